# Optimizing an MI355X kernel written in HIP

```python
import jax, jax.numpy as jnp
from jax import lax
import numpy as np

D_MODEL = 2048
BATCH = 2
SEQ = 8192
DEPTH = 1

HEAD_DIM = 128
ATTN_GROUPS = ((128, 1), (512, 4), (2048, 16))
N_GROUPS = 3
ATTN_HEADS_PER_GROUP = 8
ATTN_QKV_WIDTH = N_GROUPS * ATTN_HEADS_PER_GROUP * HEAD_DIM
ATTN_OUT_WIDTH = ATTN_HEADS_PER_GROUP * HEAD_DIM
HGRN_HEADS = 8
HGRN_KEY_DIM = 128
HGRN_VAL_DIM = 128
HGRN_WIDTH = HGRN_HEADS * HGRN_KEY_DIM
HGRN_CHUNK = 64
ROPE_THETA = 10000.0
NORM_EPS = 1e-6
D_FF = -(-8 * D_MODEL // (3 * 256)) * 256
IN_COLS = 3 * ATTN_QKV_WIDTH + 4 * HGRN_WIDTH + 2 * D_MODEL

kernel_name = "hybrid_dilated_attn_hgrn2_gated_block"


def rmsnorm(x, gain):
    xf = x.astype(jnp.float32)
    y = xf * lax.rsqrt(jnp.mean(xf * xf, axis=-1, keepdims=True) + NORM_EPS)
    return (y * gain.astype(jnp.float32)).astype(x.dtype)


def rotary(t, seq_len):
    inv_freq = ROPE_THETA ** (-jnp.arange(0, HEAD_DIM, 2, dtype=jnp.float32) / HEAD_DIM)
    ang = jnp.arange(seq_len, dtype=jnp.float32)[:, None] * inv_freq[None, :]
    cos = jnp.concatenate([jnp.cos(ang), jnp.cos(ang)], axis=-1)
    sin = jnp.concatenate([jnp.sin(ang), jnp.sin(ang)], axis=-1)
    tf = t.astype(jnp.float32)
    half = HEAD_DIM // 2
    rot = jnp.concatenate([-tf[..., half:], tf[..., :half]], axis=-1)
    return (tf * cos + rot * sin).astype(t.dtype)


def banded_causal_attention(q, k, v, back):
    *lead, L, hd = q.shape
    blk = back
    n = L // blk
    qb = q.reshape(*lead, n, blk, hd).astype(jnp.float32)
    kb = k.reshape(*lead, n, blk, hd).astype(jnp.float32)
    vb = v.reshape(*lead, n, blk, hd).astype(jnp.float32)
    zero = jnp.zeros_like(kb[..., :1, :, :])
    kk = jnp.concatenate([jnp.concatenate([zero, kb[..., :-1, :, :]], axis=-3), kb], axis=-2)
    vv = jnp.concatenate([jnp.concatenate([zero, vb[..., :-1, :, :]], axis=-3), vb], axis=-2)
    s = jnp.einsum('...nqd,...nkd->...nqk', qb, kk) * (hd ** -0.5)
    qi = jnp.arange(blk)[:, None]
    kj = jnp.arange(2 * blk)[None, :]
    dist = qi + blk - kj
    band = (dist >= 0) & (dist <= back)
    in_range = (jnp.arange(n)[:, None, None] > 0) | (kj >= blk)[None]
    s = jnp.where(band[None] & in_range, s, -jnp.inf)
    m = jnp.max(s, axis=-1, keepdims=True)
    p = jnp.exp(s - m)
    den = jnp.sum(p, axis=-1, keepdims=True)
    out = jnp.einsum('...nqk,...nkd->...nqd', p, vv) / den
    lse = (m + jnp.log(den))[..., 0]
    return out.reshape(*lead, L, hd), lse.reshape(*lead, L)


def dilated_window_attention(q, k, v, window, dilation):
    B, H, S, hd = q.shape
    back = window // dilation
    span = dilation * back
    s_pad = -(-S // span) * span

    def to_residue(t):
        t = jnp.pad(t, ((0, 0), (0, 0), (0, s_pad - S), (0, 0)))
        t = t.reshape(B, H, s_pad // dilation, dilation, hd)
        return jnp.swapaxes(t, 2, 3)

    out, lse = banded_causal_attention(to_residue(q), to_residue(k), to_residue(v), back)
    out = jnp.swapaxes(out, 2, 3).reshape(B, H, s_pad, hd)[:, :, :S]
    lse = jnp.swapaxes(lse, 2, 3).reshape(B, H, s_pad)[:, :, :S]
    return out, lse


def hgrn2_chunked(q, logf, k, v):
    B, H, S, dk = q.shape
    dv = v.shape[-1]
    n = S // HGRN_CHUNK

    def chunks(t):
        return jnp.moveaxis(t.reshape(B, H, n, HGRN_CHUNK, t.shape[-1]), 2, 0)

    causal = jnp.tril(jnp.ones((HGRN_CHUNK, HGRN_CHUNK), dtype=bool))

    def step(state, inp):
        qc, gc, kc, vc = inp
        b = jnp.cumsum(gc, axis=-2)
        o_inter = jnp.einsum('bhtk,bhkv->bhtv', qc * jnp.exp(b), state)
        rel = b[:, :, :, None, :] - b[:, :, None, :, :]
        decay = jnp.exp(jnp.where(causal[:, :, None], rel, -jnp.inf))
        a = jnp.einsum('bhtk,bhtsk,bhsk->bhts', qc, decay, kc)
        o = o_inter + jnp.einsum('bhts,bhsv->bhtv', a, vc)
        b_last = b[:, :, -1:, :]
        new_state = jnp.exp(b_last[:, :, 0, :])[..., None] * state + jnp.einsum(
            'bhsk,bhsv->bhkv', kc * jnp.exp(b_last - b), vc)
        return new_state, o

    state0 = jnp.zeros((B, H, dk, dv), jnp.float32)
    _, o = lax.scan(step, state0, (chunks(q), chunks(logf), chunks(k), chunks(v)))
    return jnp.moveaxis(o, 0, 2).reshape(B, H, S, dv)


def split_columns(proj):
    sizes = [ATTN_QKV_WIDTH] * 3 + [HGRN_WIDTH] * 4 + [D_MODEL] * 2
    points = [int(p) for p in np.cumsum(sizes)[:-1]]
    return jnp.split(proj, points, axis=-1)


def setup_inputs(seed: int = 0) -> dict:
    key = jax.random.key(seed)
    ks = jax.random.split(key, 16)
    f32 = jnp.float32

    def w(k, shape, fan_in):
        return jax.random.normal(k, shape, f32) * (fan_in ** -0.5)

    def gain(k, shape):
        return 1.0 + 0.02 * jax.random.normal(k, shape, f32)

    return {
        "x": jax.random.normal(ks[0], (BATCH, SEQ, D_MODEL), f32),
        "w_in": w(ks[1], (DEPTH, D_MODEL, IN_COLS), D_MODEL),
        "w_attn_branch": w(ks[2], (DEPTH, ATTN_OUT_WIDTH, D_MODEL), ATTN_OUT_WIDTH),
        "w_hgrn_branch": w(ks[3], (DEPTH, HGRN_HEADS * HGRN_VAL_DIM, D_MODEL), HGRN_HEADS * HGRN_VAL_DIM),
        "w_mix_out": w(ks[4], (DEPTH, D_MODEL, D_MODEL), D_MODEL),
        "hgrn_lower_bounds": 0.1 * jax.random.normal(ks[5], (DEPTH + 1, HGRN_WIDTH), f32),
        "hgrn_norm_gain": gain(ks[6], (DEPTH, HGRN_HEADS * HGRN_VAL_DIM)),
        "norm_mix_pre": gain(ks[7], (DEPTH, D_MODEL)),
        "norm_mix_post": gain(ks[8], (DEPTH, D_MODEL)),
        "w_ffn_gate_up": w(ks[9], (DEPTH, D_MODEL, 2 * D_FF), D_MODEL),
        "w_ffn_down": w(ks[10], (DEPTH, D_FF, D_MODEL), D_FF),
        "norm_ffn_pre": gain(ks[11], (DEPTH, D_MODEL)),
        "norm_ffn_post": gain(ks[12], (DEPTH, D_MODEL)),
    }


def reference(x, w_in, w_attn_branch, w_hgrn_branch, w_mix_out, hgrn_lower_bounds, hgrn_norm_gain,
              norm_mix_pre, norm_mix_post, w_ffn_gate_up, w_ffn_down, norm_ffn_pre, norm_ffn_post):
    B, S, _ = x.shape
    lower_bounds = jnp.cumsum(jax.nn.softmax(hgrn_lower_bounds.astype(jnp.float32), axis=0), axis=0)
    h = x
    for layer in range(DEPTH):
        a = rmsnorm(h, norm_mix_pre[layer])
        proj = a @ w_in[layer]
        q_a, k_a, v_a, q_r, f_r, i_r, g_r, gate_a, gate_r = split_columns(proj)

        def heads(t):
            return t.reshape(B, S, N_GROUPS, ATTN_HEADS_PER_GROUP, HEAD_DIM).transpose(2, 0, 3, 1, 4)
        qh = rotary(heads(q_a), S)
        kh = rotary(heads(k_a), S)
        vh = heads(v_a)
        outs, lses = [], []
        for g, (window, dilation) in enumerate(ATTN_GROUPS):
            o_g, lse_g = dilated_window_attention(qh[g], kh[g], vh[g], window, dilation)
            outs.append(o_g)
            lses.append(lse_g)
        mix_w = jax.nn.softmax(jnp.stack(lses, axis=0), axis=0)
        attn = jnp.einsum('gbhs,gbhsd->bshd', mix_w, jnp.stack(outs, axis=0))
        attn = attn.reshape(B, S, ATTN_OUT_WIDTH).astype(x.dtype)

        def rheads(t):
            return t.reshape(B, S, HGRN_HEADS, -1).transpose(0, 2, 1, 3).astype(jnp.float32)
        lb = lower_bounds[layer].reshape(HGRN_HEADS, HGRN_KEY_DIM)[None, :, None, :]
        q_h = jax.nn.silu(rheads(q_r))
        f = lb + (1.0 - lb) * jax.nn.sigmoid(rheads(f_r))
        r_out = hgrn2_chunked(q_h, jnp.log(f), 1.0 - f, rheads(i_r))
        r_out = r_out.transpose(0, 2, 1, 3)
        r_out = r_out * lax.rsqrt(jnp.mean(r_out * r_out, axis=-1, keepdims=True) + NORM_EPS)
        r_out = r_out * hgrn_norm_gain[layer].astype(jnp.float32).reshape(HGRN_HEADS, HGRN_VAL_DIM)
        r_out = (r_out.reshape(B, S, HGRN_HEADS * HGRN_VAL_DIM) * jax.nn.silu(g_r.astype(jnp.float32))).astype(x.dtype)

        y = jax.nn.sigmoid(gate_a) * (attn @ w_attn_branch[layer]) + jax.nn.sigmoid(gate_r) * (r_out @ w_hgrn_branch[layer])
        h = h + rmsnorm(y @ w_mix_out[layer], norm_mix_post[layer])

        a = rmsnorm(h, norm_ffn_pre[layer])
        gt, up = jnp.split(a @ w_ffn_gate_up[layer], [D_FF], axis=-1)
        ff = (jax.nn.silu(gt) * up) @ w_ffn_down[layer]
        h = h + rmsnorm(ff, norm_ffn_post[layer])
    return h
```

```cpp
#include <hip/hip_runtime.h>
#include <hip/hip_cooperative_groups.h>
#include <cstdio>
#include <cstdint>
#include <cmath>
namespace cg = cooperative_groups;

namespace pg8 {
#define PG8_LAS __attribute__((address_space(3)))
typedef unsigned short bf16_t;
typedef short bf16x8 __attribute__((ext_vector_type(8)));
typedef float f32x4 __attribute__((ext_vector_type(4)));
typedef unsigned u32x4 __attribute__((ext_vector_type(4)));
typedef unsigned u32x2 __attribute__((ext_vector_type(2)));
constexpr int BM = 256, BK = 64, HALF = 128, HTB = HALF * BK * 2, STAGE_BYTES = 8 * HTB, NXCD = 8, WGM = 4;

__host__ __device__ __forceinline__ int lds_byte(int r, int c) { const int st = (r >> 4) * 2 + (c >> 5), rr = r & 15, cc = c & 31, ob = rr * 64 + cc * 2; return st * 1024 + (ob ^ (((ob >> 9) & 1) << 5)); }
__host__ __device__ __forceinline__ void stage_rc(int b, int& R, int& C) { const int st = b / 1024, sb = b % 1024, swz = sb ^ (((sb >> 9) & 1) << 5); R = (st >> 1) * 16 + swz / 64; C = (st & 1) * 32 + (swz % 64) / 2; }
__host__ __device__ __forceinline__ int perm32(int rho) { const int n = rho >> 4, i = rho & 15; return 8 * (i >> 2) + 4 * n + (i & 3); }

struct Unit { int pm, pn, half; };
struct Gemm { const bf16_t* A; const bf16_t* Bt; int M, N, K, lda, ldb; };

struct StaticOrder {
    int nM, nN, nwg, G, c;
    __host__ __device__ void init(int M, int N, int G_, int c_) { nM = M / BM; nN = N / BM; nwg = nM * nN; G = G_; c = c_; }
    __host__ __device__ bool next(int i, Unit& u) const {
        const long L = (long)i * G + c; if (L >= nwg) return false;
        int wgid = (int)L; const int xcd_ = wgid % NXCD; { const int q = nwg / NXCD, r = nwg % NXCD, xcd = wgid % NXCD, off = wgid / NXCD; wgid = (xcd < r ? xcd * (q + 1) : r * (q + 1) + (xcd - r) * q) + off; }
        const int nig = WGM * nN, gid = wgid / nig, fm = gid * WGM, gsz = (nM - fm) < WGM ? (nM - fm) : WGM;
        u.pm = fm + ((wgid % nig) % gsz); u.pn = ((wgid % nig) / gsz + xcd_ * (nN / NXCD)) % nN; u.half = 0; return true;
    }
    __device__ __forceinline__ const char* baseA(const Gemm& g, const Unit&) const { return (const char*)g.A; }
    __device__ __forceinline__ const char* baseB(const Gemm& g, const Unit&) const { return (const char*)g.Bt; }
    __device__ __forceinline__ void a_ready(const Unit&) const {}
    __device__ __forceinline__ void done(const Unit&) const {}
};
struct PairOrder : StaticOrder {
    const bf16_t *A20, *A21, *B20, *B21;
    __device__ bool next(int i, Unit& u) const { const bool r = StaticOrder::next(i >> 1, u); u.half = i & 1; return r; }
    __device__ __forceinline__ const char* baseA(const Gemm&, const Unit& u) const { return (const char*)(u.half ? A21 : A20); }
    __device__ __forceinline__ const char* baseB(const Gemm&, const Unit& u) const { return (const char*)(u.half ? B21 : B20); }
};

typedef float f32x2_t __attribute__((ext_vector_type(2))); typedef __bf16 bf16x2_t __attribute__((ext_vector_type(2)));
__device__ __forceinline__ unsigned cvtpk(float lo, float hi) { f32x2_t v = {lo, hi}; bf16x2_t b = __builtin_convertvector(v, bf16x2_t); return __builtin_bit_cast(unsigned, b); }
__device__ __forceinline__ float bflo(unsigned w) { return __uint_as_float(w << 16); }
__device__ __forceinline__ float bfhi(unsigned w) { return __uint_as_float(w & 0xffff0000u); }
__device__ __forceinline__ float sigmoidf_(float x) { return __builtin_amdgcn_rcpf(1.f + __builtin_amdgcn_exp2f(-1.4426950408889634f * x)); }
__device__ __forceinline__ float siluf_(float x) { return x * sigmoidf_(x); }


constexpr float QSCALE = 0.08838834764831845f * 1.4426950408889634f;

struct EpiProj {
    static constexpr bool PERM = true, AFTER_DRAIN = false, TWO_STAGE = false;
    bf16_t *Q, *Kb, *V, *HG; const float* invf;
    __device__ __forceinline__ void operator()(const f32x4 (&acc)[2][2][4][2], const Unit& u, int wr, int wc, int fr, int fq) const {
        const int row0 = u.pm * BM + wr * 64 + fr;
        if (u.pn < 24) {
            const bool isq = u.pn < 12; bf16_t* base = isq ? Q : Kb; const int pnl = isq ? u.pn : u.pn - 12; const float sc = isq ? QSCALE : 1.f;
            const int head = 2 * pnl + (wc >> 1), d0 = 32 * (wc & 1) + 8 * fq;
            const f32x4 fa = *(const f32x4*)(invf + d0), fb = *(const f32x4*)(invf + d0 + 4);
            const float fe[8] = {fa[0], fa[1], fa[2], fa[3], fb[0], fb[1], fb[2], fb[3]};
#pragma unroll
            for (int ai = 0; ai < 2; ++ai)
#pragma unroll
                for (int m = 0; m < 4; ++m) {
                    const int row = row0 + ai * HALF + m * 16, pos = row & 8191;
                    const float posf = (float)pos;
                    const f32x4 l0 = acc[ai][0][m][0], l1 = acc[ai][0][m][1], h0 = acc[ai][1][m][0], h1 = acc[ai][1][m][1];
                    float lo[8] = {l0[0], l0[1], l0[2], l0[3], l1[0], l1[1], l1[2], l1[3]};
                    float hi[8] = {h0[0], h0[1], h0[2], h0[3], h1[0], h1[1], h1[2], h1[3]};
                    float cs[8], sn[8];
#pragma unroll
                    for (int e = 0; e < 8; ++e) {
                        const float ang = posf * fe[e];
                        const float kq = __builtin_rintf(ang * 0.15915494309189535f);
                        float rr = __builtin_fmaf(-kq, 6.28125f, ang); rr = __builtin_fmaf(-kq, 1.9353071795864769e-3f, rr);
                        const float tt = rr * 0.15915494309189535f;
                        cs[e] = __builtin_amdgcn_cosf(tt); sn[e] = __builtin_amdgcn_sinf(tt);
                    }
                    float ol[8], oh[8];
#pragma unroll
                    for (int e = 0; e < 8; ++e) { ol[e] = (lo[e] * cs[e] - hi[e] * sn[e]) * sc; oh[e] = (hi[e] * cs[e] + lo[e] * sn[e]) * sc; }
                    bf16_t* rowp = base + (size_t)row * 3072 + head * 128 + d0;
                    u32x4 w; w.x = cvtpk(ol[0], ol[1]); w.y = cvtpk(ol[2], ol[3]); w.z = cvtpk(ol[4], ol[5]); w.w = cvtpk(ol[6], ol[7]);
                    *(u32x4*)rowp = w;
                    w.x = cvtpk(oh[0], oh[1]); w.y = cvtpk(oh[2], oh[3]); w.z = cvtpk(oh[4], oh[5]); w.w = cvtpk(oh[6], oh[7]);
                    *(u32x4*)(rowp + 64) = w;
                }
        } else {
            bf16_t* base; int ldc, colt;
            if (u.pn < 36) { base = V; ldc = 3072; colt = (u.pn - 24) * BM; } else { base = HG; ldc = 4096; colt = (u.pn - 36) * BM; }
            const int col0 = colt + wc * 32 + 8 * fq;
#pragma unroll
            for (int ai = 0; ai < 2; ++ai)
#pragma unroll
                for (int m = 0; m < 4; ++m) { bf16_t* rowp = base + (size_t)(row0 + ai * HALF + m * 16) * ldc + col0;
#pragma unroll
                    for (int bj = 0; bj < 2; ++bj) { const f32x4 v0 = acc[ai][bj][m][0], v1 = acc[ai][bj][m][1];
                        u32x4 w; w.x = cvtpk(v0[0], v0[1]); w.y = cvtpk(v0[2], v0[3]); w.z = cvtpk(v1[0], v1[1]); w.w = cvtpk(v1[2], v1[3]);
                        *(u32x4*)(rowp + bj * HALF) = w; } }
        }
    }
};
struct EpiPlain {
    static constexpr bool PERM = true, AFTER_DRAIN = false, TWO_STAGE = false;
    bf16_t* O; int ldc;
    __device__ __forceinline__ void operator()(const f32x4 (&acc)[2][2][4][2], const Unit& u, int wr, int wc, int fr, int fq) const {
        const int row0 = u.pm * BM + wr * 64 + fr, col0 = u.pn * BM + wc * 32 + 8 * fq;
#pragma unroll
        for (int ai = 0; ai < 2; ++ai)
#pragma unroll
            for (int m = 0; m < 4; ++m) { bf16_t* rowp = O + (size_t)(row0 + ai * HALF + m * 16) * ldc + col0;
#pragma unroll
                for (int bj = 0; bj < 2; ++bj) { const f32x4 v0 = acc[ai][bj][m][0], v1 = acc[ai][bj][m][1];
                    u32x4 w; w.x = cvtpk(v0[0], v0[1]); w.y = cvtpk(v0[2], v0[3]); w.z = cvtpk(v1[0], v1[1]); w.w = cvtpk(v1[2], v1[3]);
                    *(u32x4*)(rowp + bj * HALF) = w; } }
    }
};
template <bool ACCUM> struct EpiGate {
    static constexpr bool PERM = true, AFTER_DRAIN = false, TWO_STAGE = false;
    bf16_t* Y; const bf16_t* G; int goff;
    __device__ __forceinline__ void operator()(const f32x4 (&acc)[2][2][4][2], const Unit& u, int wr, int wc, int fr, int fq) const {
        const int row0 = u.pm * BM + wr * 64 + fr, col0 = u.pn * BM + wc * 32 + 8 * fq;
#pragma unroll
        for (int ai = 0; ai < 2; ++ai) {
            u32x4 gwv[4][2], ywv[4][2];
#pragma unroll
            for (int m = 0; m < 4; ++m)
#pragma unroll
                for (int bj = 0; bj < 2; ++bj) { const size_t row = (size_t)(row0 + ai * HALF + m * 16);
                    gwv[m][bj] = *(const u32x4*)(G + row * 4096 + goff + col0 + bj * HALF);
                    if (ACCUM) ywv[m][bj] = *(const u32x4*)(Y + row * 2048 + col0 + bj * HALF); }
#pragma unroll
            for (int m = 0; m < 4; ++m) { const size_t row = (size_t)(row0 + ai * HALF + m * 16);
#pragma unroll
                for (int bj = 0; bj < 2; ++bj) {
                    const u32x4 gw = gwv[m][bj];
                    bf16_t* yp = Y + row * 2048 + col0 + bj * HALF;
                    const f32x4 v0 = acc[ai][bj][m][0], v1 = acc[ai][bj][m][1];
                    float o[8] = {v0[0], v0[1], v0[2], v0[3], v1[0], v1[1], v1[2], v1[3]};
                    const unsigned gws[4] = {gw.x, gw.y, gw.z, gw.w};
#pragma unroll
                    for (int e = 0; e < 4; ++e) { o[2 * e] *= sigmoidf_(bflo(gws[e])); o[2 * e + 1] *= sigmoidf_(bfhi(gws[e])); }
                    if (ACCUM) { const u32x4 yw = ywv[m][bj]; const unsigned yws[4] = {yw.x, yw.y, yw.z, yw.w};
#pragma unroll
                        for (int e = 0; e < 4; ++e) { o[2 * e] += bflo(yws[e]); o[2 * e + 1] += bfhi(yws[e]); } }
                    u32x4 w; w.x = cvtpk(o[0], o[1]); w.y = cvtpk(o[2], o[3]); w.z = cvtpk(o[4], o[5]); w.w = cvtpk(o[6], o[7]);
                    *(u32x4*)yp = w; } }
        }
    }
};
struct EpiGate2 {
    static constexpr bool PERM = true, AFTER_DRAIN = false, TWO_STAGE = true;
    bf16_t* Y; const bf16_t* G;
    __device__ __forceinline__ void mid(f32x4 (&acc)[2][2][4][2], const Unit& u, int wr, int wc, int fr, int fq) const {
        const int row0 = u.pm * BM + wr * 64 + fr, col0 = u.pn * BM + wc * 32 + 8 * fq;
#pragma unroll
        for (int ai = 0; ai < 2; ++ai) {
            u32x4 gav[4][2], grv[4][2];
#pragma unroll
            for (int m = 0; m < 4; ++m)
#pragma unroll
                for (int bj = 0; bj < 2; ++bj) { const bf16_t* gp = G + (size_t)(row0 + ai * HALF + m * 16) * 4096 + col0 + bj * HALF;
                    gav[m][bj] = *(const u32x4*)gp; grv[m][bj] = *(const u32x4*)(gp + 2048); }
#pragma unroll
            for (int m = 0; m < 4; ++m)
#pragma unroll
                for (int bj = 0; bj < 2; ++bj) {
                    const unsigned gas[4] = {gav[m][bj].x, gav[m][bj].y, gav[m][bj].z, gav[m][bj].w}, grs[4] = {grv[m][bj].x, grv[m][bj].y, grv[m][bj].z, grv[m][bj].w};
#pragma unroll
                    for (int e = 0; e < 4; ++e) {
                        const float ea0 = __builtin_amdgcn_exp2f(-1.4426950408889634f * bflo(gas[e])), ea1 = __builtin_amdgcn_exp2f(-1.4426950408889634f * bfhi(gas[e]));
                        const float er0 = __builtin_amdgcn_exp2f(-1.4426950408889634f * bflo(grs[e])), er1 = __builtin_amdgcn_exp2f(-1.4426950408889634f * bfhi(grs[e]));
                        const float r0 = (1.f + er0) * __builtin_amdgcn_rcpf(1.f + ea0), r1 = (1.f + er1) * __builtin_amdgcn_rcpf(1.f + ea1);
                        acc[ai][bj][m][e >> 1][(2 * e) & 3] *= r0; acc[ai][bj][m][e >> 1][(2 * e + 1) & 3] *= r1;
                    }
                }
        }
    }
    __device__ __forceinline__ void operator()(const f32x4 (&acc)[2][2][4][2], const Unit& u, int wr, int wc, int fr, int fq) const {
        const int row0 = u.pm * BM + wr * 64 + fr, col0 = u.pn * BM + wc * 32 + 8 * fq;
#pragma unroll
        for (int ai = 0; ai < 2; ++ai) {
            u32x4 grv[4][2];
#pragma unroll
            for (int m = 0; m < 4; ++m)
#pragma unroll
                for (int bj = 0; bj < 2; ++bj) grv[m][bj] = *(const u32x4*)(G + (size_t)(row0 + ai * HALF + m * 16) * 4096 + 2048 + col0 + bj * HALF);
#pragma unroll
            for (int m = 0; m < 4; ++m)
#pragma unroll
                for (int bj = 0; bj < 2; ++bj) {
                    const f32x4 v0 = acc[ai][bj][m][0], v1 = acc[ai][bj][m][1];
                    float o[8] = {v0[0], v0[1], v0[2], v0[3], v1[0], v1[1], v1[2], v1[3]};
                    const unsigned grs[4] = {grv[m][bj].x, grv[m][bj].y, grv[m][bj].z, grv[m][bj].w};
#pragma unroll
                    for (int e = 0; e < 4; ++e) { o[2 * e] *= sigmoidf_(bflo(grs[e])); o[2 * e + 1] *= sigmoidf_(bfhi(grs[e])); }
                    u32x4 w; w.x = cvtpk(o[0], o[1]); w.y = cvtpk(o[2], o[3]); w.z = cvtpk(o[4], o[5]); w.w = cvtpk(o[6], o[7]);
                    *(u32x4*)(Y + (size_t)(row0 + ai * HALF + m * 16) * 2048 + col0 + bj * HALF) = w;
                }
        }
    }
};
struct EpiF32 {
    static constexpr bool PERM = false, AFTER_DRAIN = false, TWO_STAGE = false;
    float* O; int ldc;
    __device__ __forceinline__ void operator()(const f32x4 (&acc)[2][2][4][2], const Unit& u, int wr, int wc, int fr, int fq) const {
        const int row0 = u.pm * BM + wr * 64 + fr, col0 = u.pn * BM + wc * 32 + 4 * fq;
#pragma unroll
        for (int ai = 0; ai < 2; ++ai)
#pragma unroll
            for (int m = 0; m < 4; ++m) { float* rowp = O + (size_t)(row0 + ai * HALF + m * 16) * ldc + col0;
#pragma unroll
                for (int bj = 0; bj < 2; ++bj)
#pragma unroll
                    for (int n = 0; n < 2; ++n) *(f32x4*)(rowp + bj * HALF + n * 16) = acc[ai][bj][m][n]; }
    }
};
struct EpiSwiGLU {
    static constexpr bool PERM = true, AFTER_DRAIN = false, TWO_STAGE = false;
    bf16_t* O; int ldc; const float* rs;
    __device__ __forceinline__ void operator()(const f32x4 (&acc)[2][2][4][2], const Unit& u, int wr, int wc, int fr, int fq) const {
        const int row0 = u.pm * BM + wr * 64 + fr, col0 = u.pn * HALF + wc * 32 + 8 * fq;
        float rr[2][4];
#pragma unroll
        for (int ai = 0; ai < 2; ++ai)
#pragma unroll
            for (int m = 0; m < 4; ++m) rr[ai][m] = rs[row0 + ai * HALF + m * 16];
#pragma unroll
        for (int ai = 0; ai < 2; ++ai)
#pragma unroll
            for (int m = 0; m < 4; ++m) { bf16_t* rowp = O + (size_t)(row0 + ai * HALF + m * 16) * ldc + col0; const float r_ = rr[ai][m];
                const f32x4 g0 = acc[ai][0][m][0] * r_, g1 = acc[ai][0][m][1] * r_, u0 = acc[ai][1][m][0] * r_, u1 = acc[ai][1][m][1] * r_;
                float o[8];
#pragma unroll
                for (int e = 0; e < 4; ++e) { o[e] = siluf_(g0[e]) * u0[e]; o[4 + e] = siluf_(g1[e]) * u1[e]; }
                u32x4 w; w.x = cvtpk(o[0], o[1]); w.y = cvtpk(o[2], o[3]); w.z = cvtpk(o[4], o[5]); w.w = cvtpk(o[6], o[7]);
                *(u32x4*)rowp = w; }
    }
};

template <class Epi, class Sched, bool ALIGN_EPI = false, bool SP2 = false>
__device__ __forceinline__ void gemm_phase(PG8_LAS unsigned char* lds, const Gemm g, const Sched& S, const Epi& E) {
    int tid_ = threadIdx.x; asm volatile("" : "+v"(tid_));
    const int tid = tid_, wid = __builtin_amdgcn_readfirstlane(tid >> 6), lane = tid & 63, wr = wid >> 2, wc = wid & 3, fr = lane & 15, fq = lane >> 4;
    const int K = g.K, nt = K / BK;
    unsigned voffA[2], voffB[2];
#pragma unroll
    for (int i = 0; i < 2; ++i) { int R, C; stage_rc(tid * 16 + i * 8192, R, C); const int Rb = Epi::PERM ? ((R & ~31) + perm32(R & 31)) : R;
        voffA[i] = (unsigned)(R * g.lda + C) * 2u; voffB[i] = (unsigned)(Rb * g.ldb + C) * 2u; }
    const size_t kstep = (size_t)(BK * 2);
    const size_t hstepA = (size_t)HALF * g.lda * 2, hstepB = (size_t)HALF * g.ldb * 2;
    const size_t tstepA = 2 * hstepA, tstepB = 2 * hstepB;
    const unsigned ldsw = (unsigned)wid * 1024u;
    const int aoff = lds_byte(wr * 64 + fr, fq * 8), boff = lds_byte(wc * 32 + fr, fq * 8);
#define PG8_SA(b, h) (((b) * 2 + (h)) * HTB)
#define PG8_SB(b, h) ((4 + (b) * 2 + (h)) * HTB)
#define PG8_STAGE(bufoff, gbase, voff) do { _Pragma("unroll") for (int _i = 0; _i < 2; ++_i) \
        __builtin_amdgcn_global_load_lds((const unsigned*)((const char*)(gbase) + (voff)[_i]), (PG8_LAS unsigned*)(lds + (bufoff) + ldsw + _i * 8192), 16, 0, 0); } while (0)
#define PG8_LDA(dst, b, h) do { _Pragma("unroll") for (int m = 0; m < 4; ++m) _Pragma("unroll") for (int k = 0; k < 2; ++k) dst[m][k] = *(const PG8_LAS bf16x8*)(lds + PG8_SA(b, h) + aoff + m * 2048 + k * 1024); } while (0)
#define PG8_LDB(dst, b, h) do { _Pragma("unroll") for (int n = 0; n < 2; ++n) _Pragma("unroll") for (int k = 0; k < 2; ++k) dst[n][k] = *(const PG8_LAS bf16x8*)(lds + PG8_SB(b, h) + boff + n * 2048 + k * 1024); } while (0)
#define PG8_MMA(ai, bj, At, Bt) do { __builtin_amdgcn_s_setprio(1); _Pragma("unroll") for (int m = 0; m < 4; ++m) _Pragma("unroll") for (int n = 0; n < 2; ++n) _Pragma("unroll") for (int k = 0; k < 2; ++k) \
        acc[ai][bj][m][n] = __builtin_amdgcn_mfma_f32_16x16x32_bf16(Bt[n][k], At[m][k], acc[ai][bj][m][n], 0, 0, 0); __builtin_amdgcn_s_setprio(0); } while (0)
#define PG8_WAIT_V(n) asm volatile("s_waitcnt vmcnt(" #n ")" ::: "memory")
#define PG8_WAIT_L(n) asm volatile("s_waitcnt lgkmcnt(" #n ")" ::: "memory")
#define PG8_BAR __builtin_amdgcn_s_barrier()
#define PG8_SCHED __builtin_amdgcn_sched_barrier(0)
    Unit cur, nxt; int ui = 0;
    if (!S.next(0, cur)) return;
    f32x4 acc[2][2][4][2];
#pragma unroll
    for (int a = 0; a < 2; ++a)
#pragma unroll
        for (int b = 0; b < 2; ++b)
#pragma unroll
            for (int m = 0; m < 4; ++m)
#pragma unroll
                for (int n = 0; n < 2; ++n) acc[a][b][m][n] = (f32x4){0.f, 0.f, 0.f, 0.f};
    bf16x8 At[4][2], B0[2][2], B1[2][2];
    const char* cA = S.baseA(g, cur) + (size_t)cur.pm * tstepA; const char* cB = S.baseB(g, cur) + (size_t)cur.pn * tstepB;
    S.a_ready(cur);
    if constexpr (SP2) {
        PG8_STAGE(PG8_SB(0, 0), cB, voffB); PG8_STAGE(PG8_SB(0, 1), cB + hstepB, voffB); PG8_STAGE(PG8_SA(0, 0), cA, voffA); PG8_STAGE(PG8_SA(0, 1), cA + hstepA, voffA);
        if (wr == 1) PG8_BAR;
        PG8_WAIT_V(2); PG8_BAR;
        PG8_STAGE(PG8_SB(1, 0), cB + kstep, voffB); PG8_STAGE(PG8_SA(1, 0), cA + kstep, voffA); PG8_STAGE(PG8_SB(1, 1), cB + hstepB + kstep, voffB);
        PG8_WAIT_V(6); PG8_BAR;
    } else {
        PG8_STAGE(PG8_SB(0, 0), cB, voffB); PG8_STAGE(PG8_SA(0, 0), cA, voffA); PG8_STAGE(PG8_SB(0, 1), cB + hstepB, voffB); PG8_STAGE(PG8_SA(0, 1), cA + hstepA, voffA);
        if (wr == 1) PG8_BAR;
        PG8_WAIT_V(4); PG8_BAR;
        PG8_STAGE(PG8_SB(1, 0), cB + kstep, voffB); PG8_STAGE(PG8_SA(1, 0), cA + kstep, voffA); PG8_STAGE(PG8_SB(1, 1), cB + hstepB + kstep, voffB);
        PG8_WAIT_V(6); PG8_BAR;
    }
    for (;;) {
        const bool has_next = S.next(ui + 1, nxt);
        const char* nA = has_next ? S.baseA(g, nxt) + (size_t)nxt.pm * tstepA : cA; const char* nB = has_next ? S.baseB(g, nxt) + (size_t)nxt.pn * tstepB : cB;
        for (int t = 0; t < nt; t += 2) {
            const bool last = (t == nt - 2);
            const char* a1 = cA + (size_t)(t + 1) * kstep;
            const char* a2 = last ? nA : cA + (size_t)(t + 2) * kstep; const char* b2 = last ? nB : cB + (size_t)(t + 2) * kstep;
            const char* a3 = a2 + kstep; const char* b3 = b2 + kstep;
            if (last && has_next) S.a_ready(nxt);
            if constexpr (SP2) {
            PG8_LDB(B0, 0, 0); PG8_LDB(B1, 0, 1); PG8_SCHED; PG8_LDA(At, 0, 0); PG8_STAGE(PG8_SA(1, 1), a1 + hstepA, voffA);
            PG8_WAIT_V(8); PG8_WAIT_L(0); PG8_BAR; PG8_MMA(0, 0, At, B0); PG8_MMA(0, 1, At, B1); PG8_BAR; PG8_SCHED;
            PG8_LDA(At, 0, 1); PG8_STAGE(PG8_SB(0, 0), b2, voffB); PG8_STAGE(PG8_SB(0, 1), b2 + hstepB, voffB); PG8_STAGE(PG8_SA(0, 0), a2, voffA);
            PG8_WAIT_V(8); PG8_WAIT_L(0); PG8_BAR; PG8_MMA(1, 0, At, B0); PG8_MMA(1, 1, At, B1); PG8_BAR; PG8_SCHED;
            PG8_LDB(B0, 1, 0); PG8_LDB(B1, 1, 1); PG8_SCHED; PG8_LDA(At, 1, 0); PG8_STAGE(PG8_SA(0, 1), a2 + hstepA, voffA);
            PG8_WAIT_V(8); PG8_WAIT_L(0); PG8_BAR; PG8_MMA(0, 0, At, B0); PG8_MMA(0, 1, At, B1); PG8_BAR; PG8_SCHED;
            PG8_LDA(At, 1, 1); PG8_STAGE(PG8_SB(1, 0), b3, voffB); PG8_STAGE(PG8_SB(1, 1), b3 + hstepB, voffB); PG8_STAGE(PG8_SA(1, 0), a3, voffA);
            PG8_WAIT_V(8); PG8_WAIT_L(0); PG8_BAR; PG8_MMA(1, 0, At, B0); PG8_MMA(1, 1, At, B1); PG8_BAR; PG8_SCHED;
            } else {
            PG8_LDB(B0, 0, 0); PG8_SCHED; PG8_LDA(At, 0, 0); PG8_STAGE(PG8_SA(1, 1), a1 + hstepA, voffA);
            PG8_WAIT_L(8); PG8_BAR; PG8_WAIT_L(0); PG8_MMA(0, 0, At, B0); PG8_BAR; PG8_SCHED;
            PG8_LDB(B1, 0, 1); PG8_STAGE(PG8_SB(0, 0), b2, voffB);
            PG8_BAR; PG8_WAIT_L(0); PG8_MMA(0, 1, At, B1); PG8_BAR;
            PG8_LDA(At, 0, 1); PG8_STAGE(PG8_SA(0, 0), a2, voffA);
            PG8_BAR; PG8_WAIT_L(0); PG8_MMA(1, 0, At, B0); PG8_BAR; PG8_SCHED;
            PG8_STAGE(PG8_SB(0, 1), b2 + hstepB, voffB);
            PG8_WAIT_V(6); PG8_BAR; PG8_MMA(1, 1, At, B1); PG8_BAR;
            PG8_LDB(B0, 1, 0); PG8_SCHED; PG8_LDA(At, 1, 0); PG8_STAGE(PG8_SA(0, 1), a2 + hstepA, voffA);
            PG8_WAIT_L(8); PG8_BAR; PG8_WAIT_L(0); PG8_MMA(0, 0, At, B0); PG8_BAR; PG8_SCHED;
            PG8_LDB(B1, 1, 1); PG8_STAGE(PG8_SB(1, 0), b3, voffB);
            PG8_BAR; PG8_WAIT_L(0); PG8_MMA(0, 1, At, B1); PG8_BAR;
            PG8_LDA(At, 1, 1); PG8_STAGE(PG8_SA(1, 0), a3, voffA);
            PG8_BAR; PG8_WAIT_L(0); PG8_MMA(1, 0, At, B0); PG8_BAR; PG8_SCHED;
            PG8_STAGE(PG8_SB(1, 1), b3 + hstepB, voffB);
            PG8_WAIT_V(6); PG8_BAR; PG8_MMA(1, 1, At, B1); PG8_BAR;
            }
        }
        if constexpr (ALIGN_EPI) { if (wr == 0) PG8_BAR; }
        bool keep_acc = false;
        if constexpr (Epi::TWO_STAGE) { if (cur.half == 0) { E.mid(acc, cur, wr, wc, fr, fq); keep_acc = true; } else E(acc, cur, wr, wc, fr, fq); }
        else if constexpr (!Epi::AFTER_DRAIN) { E(acc, cur, wr, wc, fr, fq); S.done(cur); }
        if (!has_next) break;
        if (!keep_acc)
#pragma unroll
        for (int a = 0; a < 2; ++a)
#pragma unroll
            for (int b = 0; b < 2; ++b)
#pragma unroll
                for (int m = 0; m < 4; ++m)
#pragma unroll
                    for (int n = 0; n < 2; ++n) acc[a][b][m][n] = (f32x4){0.f, 0.f, 0.f, 0.f};
        cur = nxt; cA = nA; cB = nB; ++ui;
        if constexpr (ALIGN_EPI) { if (wr == 1) PG8_BAR; }
    }
    PG8_WAIT_V(0);
    if constexpr (!ALIGN_EPI) { if (wr == 0) PG8_BAR; }
    PG8_BAR;
#undef PG8_SA
#undef PG8_SB
#undef PG8_STAGE
#undef PG8_LDA
#undef PG8_LDB
#undef PG8_MMA
#undef PG8_WAIT_V
#undef PG8_WAIT_L
#undef PG8_BAR
#undef PG8_SCHED
}
}

using pg8::bf16_t; using pg8::bf16x8; using pg8::f32x4; using pg8::u32x4; using pg8::u32x2; using pg8::cvtpk; using pg8::bflo; using pg8::bfhi; using pg8::sigmoidf_; using pg8::siluf_;
typedef float f32x16 __attribute__((ext_vector_type(16)));
typedef short s16x4 __attribute__((ext_vector_type(4)));
typedef short v4i16_t __attribute__((ext_vector_type(4)));
#define LAS __attribute__((address_space(3)))
#define MFMA32(a, b, c) __builtin_amdgcn_mfma_f32_32x32x16_bf16((a), (b), (c), 0, 0, 0)

constexpr int NWAVES = 8, NTHR = 512;
constexpr int MTOK = 16384, DM = 2048, SEQ = 8192, DFF = 5632, NIN = 17408;
constexpr float EPS = 1e-6f;
constexpr size_t MiB = 1u << 20;
constexpr size_t WS_BAR = 65536, WS_BAR_BYTES = 16384;
constexpr size_t WS_R2 = 327680;
constexpr size_t WS_RSTD0 = 262144;
constexpr size_t WS_LB = 0, WS_LSE = 1 * MiB, WS_DEC = 3 * MiB, WS_ROPE = 4 * MiB, WS_WIN = 8 * MiB, WS_XN = 76 * MiB, WS_Q = 140 * MiB, WS_K = 236 * MiB, WS_V = 332 * MiB, WS_S = 428 * MiB;
constexpr size_t WS_WPA = 8 * MiB, WS_WPR = 12 * MiB, WS_WO = 16 * MiB, WS_WDN = 24 * MiB;
constexpr size_t WS_WING = WS_WIN + (size_t)13312 * 2048 * 2;
constexpr size_t WS_G = 236 * MiB, WS_WGU = 364 * MiB;
constexpr size_t WS_Y = WS_S, WS_Z = 236 * MiB, WS_A2 = WS_XN, WS_FFH = 140 * MiB, WS_Z2 = 316 * MiB;
constexpr size_t WS_END = 492 * MiB;
constexpr int LDS_BYTES = 147456;

struct Args { const float* in[13]; float* out; unsigned char* ws; float inv_freq[64]; };

__device__ __forceinline__ int crow(int reg, int h) { return (reg & 3) + 8 * (reg >> 2) + 4 * h; }
__device__ __forceinline__ float wave_sum(float v) {
#pragma unroll
    for (int o = 1; o < 64; o <<= 1) v += __shfl_xor(v, o);
    return v;
}
__device__ __forceinline__ bf16x8 pack8(const f32x16& x, int s8) {
    u32x4 p; p.x = cvtpk(x[s8 + 0], x[s8 + 1]); p.y = cvtpk(x[s8 + 2], x[s8 + 3]); p.z = cvtpk(x[s8 + 4], x[s8 + 5]); p.w = cvtpk(x[s8 + 6], x[s8 + 7]);
    return __builtin_bit_cast(bf16x8, p);
}
__device__ __forceinline__ s16x4 trd(const LAS unsigned char* p) { return __builtin_bit_cast(s16x4, __builtin_amdgcn_ds_read_tr16_b64_v4i16((LAS v4i16_t*)p)); }


#define XB_TMO      128
#define XB_XCNT(j)  (256  + 64 * (j))
#define XB_XSUB(j)  (1280 + 64 * (j))
#define XB_XGEN(j)  (2304 + 64 * (j))
#define XB_TOP      3328
#define XB_TOPGEN   3392
#define XCD_BAR_WORDS 3456
#define XB_SPIN_CAP (1u << 20)
__device__ __forceinline__ unsigned xb_ld(unsigned* p)              { return __hip_atomic_load(p, __ATOMIC_RELAXED, __HIP_MEMORY_SCOPE_AGENT); }
__device__ __forceinline__ unsigned xb_add(unsigned* p, unsigned v) { return __hip_atomic_fetch_add(p, v, __ATOMIC_RELAXED, __HIP_MEMORY_SCOPE_AGENT); }
__device__ __forceinline__ unsigned xb_xcc_id() { return (unsigned)__builtin_amdgcn_s_getreg((3 << 11) | 20) & 0xFu; }
#define XB_SPIN(cond, bar) do { unsigned _sp = 0; while (cond) { __builtin_amdgcn_s_sleep(1); \
    if ((++_sp & 255u) == 0u) { if (xb_ld(&(bar)[XB_TMO])) break; if (_sp > XB_SPIN_CAP) { atomicAdd(&(bar)[XB_TMO], 1u); break; } } } } while (0)
struct XcdBarrier { unsigned* bar; unsigned x; volatile LAS unsigned* st; };
__device__ __forceinline__ XcdBarrier xcd_barrier_post(unsigned* bar, volatile LAS unsigned* st) {
    XcdBarrier b; b.bar = bar; b.x = xb_xcc_id(); b.st = st;
    if (threadIdx.x == 0) (void)xb_add(&bar[XB_XCNT(b.x)], 1u);
    return b;
}
__device__ __forceinline__ void xcd_barrier_complete(unsigned* bar, unsigned x, unsigned& nloc, unsigned& nx) {
    const unsigned G = gridDim.x * gridDim.y * gridDim.z;
    unsigned sum, cnt, mine, sp = 0u;
    for (;;) {
        sum = 0u; cnt = 0u; mine = 0u;
#pragma unroll
        for (unsigned j = 0; j < 16; ++j) { const unsigned c = xb_ld(&bar[XB_XCNT(j)]); sum += c; cnt += (c > 0u) ? 1u : 0u; mine = (j == x) ? c : mine; }
        if (sum == G) break;
        __builtin_amdgcn_s_sleep(1);
        if ((++sp & 255u) == 0u) { if (xb_ld(&bar[XB_TMO])) break; if (sp > XB_SPIN_CAP) { atomicAdd(&bar[XB_TMO], 1u); break; } }
    }
    nloc = mine > 0u ? mine : 1u; nx = cnt > 0u ? cnt : 1u;
}
__device__ __forceinline__ void xcd_barrier(const XcdBarrier& b) {
    asm volatile("s_waitcnt vmcnt(0)" ::: "memory");
    __syncthreads();
    if (threadIdx.x == 0) {
        unsigned* bar = b.bar;
        __builtin_amdgcn_s_waitcnt(0);
        unsigned nloc = b.st[0], nx = b.st[1];
        if (nloc == 0u) { xcd_barrier_complete(bar, b.x, nloc, nx); b.st[0] = nloc; b.st[1] = nx; }
        const unsigned old = xb_add(&bar[XB_XSUB(b.x)], 1u);
        const unsigned gen = old / nloc;
        if (old + 1u == (gen + 1u) * nloc) {
            __builtin_amdgcn_fence(__ATOMIC_RELEASE, "agent");
            asm volatile("s_waitcnt vmcnt(0)" ::: "memory");
            const unsigned og = xb_add(&bar[XB_TOP], 1u);
            const unsigned tg = og / nx;
            if (og + 1u == (tg + 1u) * nx) xb_add(&bar[XB_TOPGEN], 1u);
            else XB_SPIN(xb_ld(&bar[XB_TOPGEN]) == tg, bar);
            __builtin_amdgcn_fence(__ATOMIC_ACQUIRE, "agent");
            xb_add(&bar[XB_XGEN(b.x)], 1u);
            asm volatile("s_waitcnt vmcnt(0)" ::: "memory");
        } else {
            XB_SPIN(xb_ld(&bar[XB_XGEN(b.x)]) == gen, bar);
            __builtin_amdgcn_fence(__ATOMIC_ACQUIRE, "agent");
            asm volatile("s_waitcnt vmcnt(0)" ::: "memory");
        }
    }
    __syncthreads();
}

template <int MODE> __device__ __forceinline__ int wmap(int n) {
    if (MODE == 1) { if (n < 6144) { const int pn = n >> 8, x = n & 255, hh = x >> 7, dd = x & 127, bj = dd >> 6, dl = dd & 63; return (pn << 8) + (bj << 7) + (hh << 6) + dl; } return n; }
    if (MODE == 2) { const int up = n >= DFF ? 1 : 0; const int j = up ? n - DFF : n; return ((j >> 7) << 8) + (up << 7) + (j & 127); }
    return n;
}
template <int MODE> __device__ __forceinline__ void transpose_load(const float* W, int N, int item, int lane, float (&v)[32]) {
    const int nblk = N / 32, kb = item / nblk, nb = item % nblk, k0 = 64 * kb, n0 = 32 * nb;
    const float* p = W + (size_t)(k0 + (lane >> 5)) * N + n0 + (lane & 31);
#pragma unroll
    for (int i = 0; i < 32; ++i) v[i] = p[(size_t)(2 * i) * N];
}
template <int MODE> __device__ __forceinline__ void transpose_store(const float (&v)[32], int K, int N, bf16_t* WT, LAS float* scr, int item, int lane, const float* ksc) {
    const int nblk = N / 32, kb = item / nblk, nb = item % nblk, k0 = 64 * kb, n0 = 32 * nb;
#pragma unroll
    for (int i = 0; i < 32; ++i) { const int kk = 2 * i + (lane >> 5); scr[kk * 33 + (lane & 31)] = v[i]; }
    asm volatile("s_waitcnt lgkmcnt(0)" ::: "memory");
    const int c = lane & 7; const int d0 = wmap<MODE>(n0);
    f32x4 ka = (f32x4){1.f, 1.f, 1.f, 1.f}, kb_ = ka;
    if (MODE == 2) { ka = *(const f32x4*)(ksc + k0 + 8 * c); kb_ = *(const f32x4*)(ksc + k0 + 8 * c + 4); }
#pragma unroll
    for (int j = 0; j < 4; ++j) { const int n = (lane >> 3) + 8 * j; const LAS float* s = scr + (8 * c) * 33 + n;
        u32x4 o; o.x = cvtpk(s[0 * 33] * ka[0], s[1 * 33] * ka[1]); o.y = cvtpk(s[2 * 33] * ka[2], s[3 * 33] * ka[3]); o.z = cvtpk(s[4 * 33] * kb_[0], s[5 * 33] * kb_[1]); o.w = cvtpk(s[6 * 33] * kb_[2], s[7 * 33] * kb_[3]);
        *(u32x4*)(WT + (size_t)(d0 + n) * K + k0 + 8 * c) = o; }
    asm volatile("s_waitcnt lgkmcnt(0)" ::: "memory");
}
template <int MODE> __device__ __forceinline__ void transpose_all(const float* W, int K, int N, bf16_t* WT, LAS unsigned char* lds, int gw, int ngw, int wave, int lane, const float* ksc = nullptr) {
    LAS float* scr = (LAS float*)(lds + wave * 16384);
    const int nitems = (K / 64) * (N / 32);
    float cur[32], nxt[32];
    if (gw < nitems) transpose_load<MODE>(W, N, gw, lane, cur);
    for (int it = gw; it < nitems; it += ngw) {
        const bool more = it + ngw < nitems;
        if (more) transpose_load<MODE>(W, N, it + ngw, lane, nxt);
        transpose_store<MODE>(cur, K, N, WT, scr, it, lane, ksc);
        if (more) {
#pragma unroll
            for (int i = 0; i < 32; ++i) cur[i] = nxt[i];
        }
    }
}

__device__ __forceinline__ void attn_unit(LAS unsigned char* lds, int a, const bf16_t* Qm, const bf16_t* Km, const bf16_t* Vm, bf16_t* Om, float* lse) {
    const int tid = threadIdx.x, lane = tid & 63, wid = __builtin_amdgcn_readfirstlane(tid >> 6), r = lane & 31, h = lane >> 5;
    const int g = a >> 10; int rem = a & 1023; const int b = rem >> 9; rem &= 511; const int hd = rem >> 6, blk = rem & 63;
    const int dsh = 2 * g, nsh = 6 - dsh;
    const int res = blk >> nsh, ub = blk & ((1 << nsh) - 1), u0 = ub * 128;
    const int col = (g * 8 + hd) * 128;
    const size_t rowbase = (size_t)b * SEQ + res;
    LAS unsigned char* Ks = lds; LAS unsigned char* Vs = lds + 65536;
    const int kk_lo = (u0 == 0) ? 128 : 0;
    {
        u32x4 kvr[8], vvr[8];
#pragma unroll
        for (int i = 0; i < 8; ++i) {
            const int idx = tid + 512 * i, kk = idx >> 4, c = idx & 15;
            const int uu = u0 - 128 + (kk < kk_lo ? kk_lo : kk);
            const size_t grow = rowbase + ((size_t)uu << dsh);
            kvr[i] = *(const u32x4*)(Km + grow * 3072 + col + c * 8);
            vvr[i] = *(const u32x4*)(Vm + grow * 3072 + col + c * 8);
        }
#pragma unroll
        for (int i = 0; i < 8; ++i) {
            const int idx = tid + 512 * i, kk = idx >> 4, c = idx & 15;
            *(LAS u32x4*)(Ks + kk * 256 + ((c ^ (kk & 15)) << 4)) = kvr[i];
            *(LAS u32x4*)(Vs + kk * 256 + (((c >> 1) ^ (kk & 7)) << 5) + ((c & 1) << 4)) = vvr[i];
        }
    }
    const int qj = lane & 15, qd = lane >> 4;
    const size_t qrow = rowbase + ((size_t)(u0 + 16 * wid + qj) << dsh);
    bf16x8 qf[4];
#pragma unroll
    for (int ks = 0; ks < 4; ++ks) qf[ks] = __builtin_bit_cast(bf16x8, *(const u32x4*)(Qm + qrow * 3072 + col + 32 * ks + 8 * qd));
    __syncthreads();
    f32x4 sc[9];
    const int tskip = (u0 == 0) ? (8 - wid) : 0;
#pragma unroll
    for (int t = 0; t < 9; ++t) {
        f32x4 acc = (f32x4){0.f, 0.f, 0.f, 0.f};
        if (t >= tskip) {
            const int kr = 16 * wid + 16 * t + qj;
#pragma unroll
            for (int ks = 0; ks < 4; ++ks) { const bf16x8 kf = *(const LAS bf16x8*)(Ks + kr * 256 + (((4 * ks + qd) ^ (kr & 15)) << 4)); acc = __builtin_amdgcn_mfma_f32_16x16x32_bf16(kf, qf[ks], acc, 0, 0, 0); }
        } else acc = (f32x4){-INFINITY, -INFINITY, -INFINITY, -INFINITY};
        sc[t] = acc;
    }
#pragma unroll
    for (int e = 0; e < 4; ++e) { if (4 * qd + e < qj) sc[0][e] = -INFINITY; if (4 * qd + e > qj) sc[8][e] = -INFINITY; }
    float mx = sc[8][0];
#pragma unroll
    for (int t = 0; t < 9; ++t)
#pragma unroll
        for (int e = 0; e < 4; ++e) mx = fmaxf(mx, sc[t][e]);
    mx = fmaxf(mx, __shfl_xor(mx, 16)); mx = fmaxf(mx, __shfl_xor(mx, 32));
    float l = 0.f;
#pragma unroll
    for (int t = 0; t < 9; ++t)
#pragma unroll
        for (int e = 0; e < 4; ++e) { sc[t][e] = __builtin_amdgcn_exp2f(sc[t][e] - mx); l += sc[t][e]; }
    l += __shfl_xor(l, 16); l += __shfl_xor(l, 32);
    f32x4 o[8];
#pragma unroll
    for (int db = 0; db < 8; ++db) o[db] = (f32x4){0.f, 0.f, 0.f, 0.f};
    const int q4 = (lane & 15) >> 2, p4 = lane & 3;
#pragma unroll
    for (int st = 0; st < 5; ++st) {
        if (2 * st + 1 < tskip) continue;
        u32x4 pw; pw.x = cvtpk(sc[2 * st][0], sc[2 * st][1]); pw.y = cvtpk(sc[2 * st][2], sc[2 * st][3]);
        if (st < 4) { pw.z = cvtpk(sc[2 * st + 1][0], sc[2 * st + 1][1]); pw.w = cvtpk(sc[2 * st + 1][2], sc[2 * st + 1][3]); } else { pw.z = 0u; pw.w = 0u; }
        const bf16x8 pb = __builtin_bit_cast(bf16x8, pw);
        const int key0 = 16 * wid + 32 * st + 4 * qd + q4;
        const int key1 = (st < 4) ? key0 + 16 : key0;
#pragma unroll
        for (int db = 0; db < 8; ++db) {
            const int so = ((db ^ (key0 & 7)) << 5) + 8 * p4;
            const s16x4 lo = trd(Vs + key0 * 256 + so), hi = trd(Vs + key1 * 256 + so);
            const bf16x8 af = __builtin_shufflevector(lo, hi, 0, 1, 2, 3, 4, 5, 6, 7);
            o[db] = __builtin_amdgcn_mfma_f32_16x16x32_bf16(af, pb, o[db], 0, 0, 0);
        }
    }
    const float inv = 1.f / l;
    __syncthreads();
    LAS unsigned char* stg = lds + wid * 4608;
#pragma unroll
    for (int db = 0; db < 8; ++db) {
        u32x2 w; w.x = cvtpk(o[db][0] * inv, o[db][1] * inv); w.y = cvtpk(o[db][2] * inv, o[db][3] * inv);
        *(LAS u32x2*)(stg + qj * 272 + (16 * db + 4 * qd) * 2) = w;
    }
    asm volatile("s_waitcnt lgkmcnt(0)" ::: "memory");
#pragma unroll
    for (int ps = 0; ps < 4; ++ps) {
        const int row = ps * 4 + (lane >> 4), ch = lane & 15;
        const u32x4 v = *(const LAS u32x4*)(stg + row * 272 + ch * 16);
        const size_t grow = rowbase + ((size_t)(u0 + 16 * wid + row) << dsh);
        __builtin_nontemporal_store(v, (u32x4*)(Om + grow * 3072 + col + ch * 8));
    }
    if (qd == 0) lse[((size_t)g * MTOK + qrow) * 8 + hd] = mx + __builtin_amdgcn_logf(l);
    __syncthreads();
}

constexpr int HL_GB = 0, HL_PP = 33024, HL_RED = 35072, HL_QT = 36864, HL_KT = 53248, HL_KHT = 69632, HL_VT = 86016, HL_STG = 102400;
template <bool PASS_A> __device__ __forceinline__ void hgrn_setup(LAS unsigned char* lds, int b, int hd, int c, const bf16_t* HG, const float* LB) {
    const int tid = threadIdx.x;
    LAS float* GB = (LAS float*)(lds + HL_GB); LAS float* PP = (LAS float*)(lds + HL_PP);
    const size_t row0 = (size_t)b * SEQ + (size_t)c * 64;
#pragma unroll
    for (int i = 0; i < 2; ++i) {
        const int q = tid + 512 * i, t = q >> 4, cc = q & 15;
        const bf16_t* rp = HG + (row0 + t) * 4096 + hd * 128 + cc * 8;
        const u32x4 fw = *(const u32x4*)(rp + 1024), iw = *(const u32x4*)(rp + 2048);
        if (!PASS_A) { const u32x4 qw = *(const u32x4*)(rp); *(LAS u32x4*)(lds + HL_QT + t * 256 + ((cc ^ (t & 15)) << 4)) = qw; }
        *(LAS u32x4*)(lds + HL_KT + t * 256 + ((cc ^ (t & 15)) << 4)) = fw;
        *(LAS u32x4*)(lds + HL_STG + t * 272 + cc * 16) = iw;
    }
    __syncthreads();
    float omr[2][8];
#pragma unroll
    for (int i = 0; i < 2; ++i) {
        const int q = tid + 512 * i, t = q & 63, cc = q >> 6;
        const u32x4 fw = *(const LAS u32x4*)(lds + HL_KT + t * 256 + ((cc ^ (t & 15)) << 4));
        const unsigned fws[4] = {fw.x, fw.y, fw.z, fw.w};
#pragma unroll
        for (int e = 0; e < 8; ++e) {
            const float x = (e & 1) ? bfhi(fws[e >> 1]) : bflo(fws[e >> 1]);
            const float lbv = LB[hd * 128 + cc * 8 + e];
            const float ef = __builtin_amdgcn_exp2f(-1.4426950408889634f * x), sg = __builtin_amdgcn_rcpf(1.f + ef);
            const float f = lbv + (1.f - lbv) * sg;
            omr[i][e] = (1.f - lbv) * ef * sg;
            GB[t * 129 + cc * 8 + e] = __builtin_amdgcn_logf(f);
        }
    }
    __syncthreads();
    {
        const int k = tid & 127, part = tid >> 7; float accv = 0.f;
#pragma unroll
        for (int j = 0; j < 16; ++j) { const int t = 16 * part + j; accv += GB[t * 129 + k]; GB[t * 129 + k] = accv; }
        PP[part * 128 + k] = accv;
        __syncthreads();
        float off = 0.f;
        for (int pp = 0; pp < part; ++pp) off += PP[pp * 128 + k];
        if (part > 0) {
#pragma unroll
            for (int j = 0; j < 16; ++j) { const int t = 16 * part + j; GB[t * 129 + k] += off; }
        }
        if (part == 0) ((LAS float*)(lds + HL_RED))[k] = (PP[k] + PP[128 + k]) + (PP[256 + k] + PP[384 + k]);
    }
    __syncthreads();
#pragma unroll
    for (int i = 0; i < 2; ++i) {
        const int q = tid + 512 * i, t = q & 63, cc = q >> 6;
        const u32x4 qw = *(const LAS u32x4*)(lds + HL_QT + t * 256 + ((cc ^ (t & 15)) << 4)), fw = *(const LAS u32x4*)(lds + HL_KT + t * 256 + ((cc ^ (t & 15)) << 4)),
                    iw = *(const LAS u32x4*)(lds + HL_STG + t * 272 + cc * 16);
        const unsigned qws[4] = {qw.x, qw.y, qw.z, qw.w}, fws[4] = {fw.x, fw.y, fw.z, fw.w}, iws[4] = {iw.x, iw.y, iw.z, iw.w};
        float qt[8], kt[8];
#pragma unroll
        for (int e = 0; e < 8; ++e) {
            const int k = cc * 8 + e;
            const float bb = GB[t * 129 + k];
            const float om = omr[i][e];
            if (PASS_A) {
                const float bl = ((const LAS float*)(lds + HL_RED))[k];
                const float kh = om * __builtin_amdgcn_exp2f(bl - bb);
                const unsigned khb = cvtpk(kh, 0.f) & 0xffffu;
                *(LAS unsigned short*)(lds + HL_KHT + k * 128 + (((t >> 3) ^ (k & 7)) << 4) + (t & 7) * 2) = (unsigned short)khb;
            } else {
                const float qx = (e & 1) ? bfhi(qws[e >> 1]) : bflo(qws[e >> 1]);
                const float eb = __builtin_amdgcn_exp2f(bb), eq1 = 1.f + __builtin_amdgcn_exp2f(-1.4426950408889634f * qx);
                const float rr = __builtin_amdgcn_rcpf(eb * eq1);
                qt[e] = qx * eb * (rr * eb);
                kt[e] = om * (rr * eq1);
            }
            const unsigned iv = (e & 1) ? (iws[e >> 1] >> 16) : (iws[e >> 1] & 0xffffu);
            *(LAS unsigned short*)(lds + HL_VT + k * 128 + (((t >> 3) ^ (k & 7)) << 4) + (t & 7) * 2) = (unsigned short)iv;
        }
        if (!PASS_A) {
            u32x4 w; w.x = cvtpk(qt[0], qt[1]); w.y = cvtpk(qt[2], qt[3]); w.z = cvtpk(qt[4], qt[5]); w.w = cvtpk(qt[6], qt[7]);
            *(LAS u32x4*)(lds + HL_QT + t * 256 + ((cc ^ (t & 15)) << 4)) = w;
            w.x = cvtpk(kt[0], kt[1]); w.y = cvtpk(kt[2], kt[3]); w.z = cvtpk(kt[4], kt[5]); w.w = cvtpk(kt[6], kt[7]);
            *(LAS u32x4*)(lds + HL_KT + t * 256 + ((cc ^ (t & 15)) << 4)) = w;
        }
    }
    __syncthreads();
}
__device__ __forceinline__ void hgrn_pass_a(LAS unsigned char* lds, int unit, const bf16_t* HG, const float* LB, bf16_t* S, float* DEC) {
    const int tid = threadIdx.x, lane = tid & 63, wid = __builtin_amdgcn_readfirstlane(tid >> 6), r = lane & 31, h = lane >> 5;
    const int b = unit >> 10, hd = (unit >> 7) & 7, c = unit & 127;
    hgrn_setup<true>(lds, b, hd, c, HG, LB);
    const int vb = wid >> 1;
    bf16_t* Sg = S + (size_t)unit * 16384;
#pragma unroll
    for (int kbi = 0; kbi < 2; ++kbi) {
        const int kb = 2 * (wid & 1) + kbi;
        f32x16 acc;
#pragma unroll
        for (int i = 0; i < 16; ++i) acc[i] = 0.f;
        const int v = 32 * vb + r, k = 32 * kb + r;
#pragma unroll
        for (int ts = 0; ts < 4; ++ts) {
            const int ch = 2 * ts + h;
            const bf16x8 af = *(const LAS bf16x8*)(lds + HL_VT + v * 128 + ((ch ^ (v & 7)) << 4));
            const bf16x8 bf = *(const LAS bf16x8*)(lds + HL_KHT + k * 128 + ((ch ^ (k & 7)) << 4));
            acc = MFMA32(af, bf, acc);
        }
#pragma unroll
        for (int i = 0; i < 16; ++i) *(LAS unsigned short*)(lds + HL_GB + (32 * vb + crow(i, h)) * 256 + k * 2) = (unsigned short)(cvtpk(acc[i], 0.f) & 0xffffu);
    }
    __syncthreads();
#pragma unroll
    for (int i = 0; i < 4; ++i) { const int q = tid + 512 * i; *(u32x4*)(Sg + q * 8) = *(const LAS u32x4*)(lds + HL_GB + q * 16); }
    if (tid < 128) DEC[(size_t)unit * 128 + tid] = __builtin_amdgcn_exp2f(((const LAS float*)(lds + HL_RED))[tid]);
    __syncthreads();
}
__device__ __forceinline__ void hgrn_pass_c(LAS unsigned char* lds, int unit, bf16_t* HG, const float* LB, const bf16_t* S, const float* hgain, const bf16_t* Og, const float* lse) {
    const int tid = threadIdx.x, lane = tid & 63, wid = __builtin_amdgcn_readfirstlane(tid >> 6), r = lane & 31, h = lane >> 5;
    const int b = unit >> 10, hd = (unit >> 7) & 7, c = unit & 127;
    hgrn_setup<false>(lds, b, hd, c, HG, LB);
    const int vb = wid >> 1, tb = wid & 1;
    const bf16_t* Sg = S + (size_t)unit * 16384;
    f32x16 o;
#pragma unroll
    for (int i = 0; i < 16; ++i) o[i] = 0.f;
    const int trow = 32 * tb + r, vrow = 32 * vb + r;
    bf16x8 qf[8];
#pragma unroll
    for (int ks = 0; ks < 8; ++ks) qf[ks] = *(const LAS bf16x8*)(lds + HL_QT + trow * 256 + (((2 * ks + h) ^ (trow & 15)) << 4));
#pragma unroll
    for (int ks = 0; ks < 8; ++ks) { const bf16x8 af = __builtin_bit_cast(bf16x8, *(const u32x4*)(Sg + vrow * 128 + 16 * ks + 8 * h)); o = MFMA32(af, qf[ks], o); }
    for (int sb = 0; sb <= tb; ++sb) {
        f32x16 X;
#pragma unroll
        for (int i = 0; i < 16; ++i) X[i] = 0.f;
        const int srow = 32 * sb + r;
#pragma unroll
        for (int ks = 0; ks < 8; ++ks) { const bf16x8 af = *(const LAS bf16x8*)(lds + HL_KT + srow * 256 + (((2 * ks + h) ^ (srow & 15)) << 4)); X = MFMA32(af, qf[ks], X); }
        if (sb == tb) {
#pragma unroll
            for (int i = 0; i < 16; ++i) if (crow(i, h) > r) X[i] = 0.f;
        }
#pragma unroll
        for (int ss = 0; ss < 2; ++ss) {
            const bf16x8 pb = pack8(X, 8 * ss);
            const int c0 = 4 * sb + 2 * ss;
            const u32x2 lo = *(const LAS u32x2*)(lds + HL_VT + vrow * 128 + ((c0 ^ (vrow & 7)) << 4) + 8 * h);
            const u32x2 hi = *(const LAS u32x2*)(lds + HL_VT + vrow * 128 + (((c0 + 1) ^ (vrow & 7)) << 4) + 8 * h);
            u32x4 aw; aw.x = lo.x; aw.y = lo.y; aw.z = hi.x; aw.w = hi.y;
            o = MFMA32(__builtin_bit_cast(bf16x8, aw), pb, o);
        }
    }
    float ssq = 0.f;
#pragma unroll
    for (int i = 0; i < 16; ++i) ssq += o[i] * o[i];
    ssq += __shfl_xor(ssq, 32);
    LAS float* RED = (LAS float*)(lds + HL_RED);
    if (h == 0) RED[vb * 64 + trow] = ssq;
    __syncthreads();
    const float tot = (RED[trow] + RED[64 + trow]) + (RED[128 + trow] + RED[192 + trow]);
    const float rstd = rsqrtf(tot * (1.f / 128.f) + EPS);
#pragma unroll
    for (int gq = 0; gq < 4; ++gq) {
        u32x2 w; w.x = cvtpk(o[4 * gq] * rstd, o[4 * gq + 1] * rstd); w.y = cvtpk(o[4 * gq + 2] * rstd, o[4 * gq + 3] * rstd);
        *(LAS u32x2*)(lds + HL_STG + trow * 272 + (32 * vb + 8 * gq + 4 * h) * 2) = w;
    }
    __syncthreads();
    const size_t row0 = (size_t)b * SEQ + (size_t)c * 64;
#pragma unroll
    for (int i = 0; i < 2; ++i) {
        const int q = tid + 512 * i, t = q >> 4, cc = q & 15;
        const size_t row = row0 + t;
        bf16_t* rp = HG + row * 4096 + hd * 128 + cc * 8;
        const u32x4 ov = *(const LAS u32x4*)(lds + HL_STG + t * 272 + cc * 16);
        const u32x4 gw = *(const u32x4*)(rp + 3072);
        const f32x4 ga = *(const f32x4*)(hgain + hd * 128 + cc * 8), gb = *(const f32x4*)(hgain + hd * 128 + cc * 8 + 4);
        const float gn[8] = {ga[0], ga[1], ga[2], ga[3], gb[0], gb[1], gb[2], gb[3]};
        const unsigned ovs[4] = {ov.x, ov.y, ov.z, ov.w}, gws[4] = {gw.x, gw.y, gw.z, gw.w};
        float ro[8];
#pragma unroll
        for (int e = 0; e < 4; ++e) { ro[2 * e] = bflo(ovs[e]) * gn[2 * e] * siluf_(bflo(gws[e])); ro[2 * e + 1] = bfhi(ovs[e]) * gn[2 * e + 1] * siluf_(bfhi(gws[e])); }
        const float l0 = lse[((size_t)0 * MTOK + row) * 8 + hd], l1 = lse[((size_t)1 * MTOK + row) * 8 + hd], l2 = lse[((size_t)2 * MTOK + row) * 8 + hd];
        const float mx = fmaxf(l0, fmaxf(l1, l2));
        float w0 = __builtin_amdgcn_exp2f(l0 - mx), w1 = __builtin_amdgcn_exp2f(l1 - mx), w2 = __builtin_amdgcn_exp2f(l2 - mx);
        const float wi = 1.f / (w0 + w1 + w2); w0 *= wi; w1 *= wi; w2 *= wi;
        const bf16_t* op = Og + row * 3072 + hd * 128 + cc * 8;
        const u32x4 a0 = *(const u32x4*)(op), a1 = *(const u32x4*)(op + 1024), a2 = *(const u32x4*)(op + 2048);
        const unsigned a0s[4] = {a0.x, a0.y, a0.z, a0.w}, a1s[4] = {a1.x, a1.y, a1.z, a1.w}, a2s[4] = {a2.x, a2.y, a2.z, a2.w};
        u32x4 wr_, wa_;
        unsigned wrs[4], was[4];
#pragma unroll
        for (int e = 0; e < 4; ++e) {
            wrs[e] = cvtpk(ro[2 * e], ro[2 * e + 1]);
            was[e] = cvtpk(w0 * bflo(a0s[e]) + w1 * bflo(a1s[e]) + w2 * bflo(a2s[e]), w0 * bfhi(a0s[e]) + w1 * bfhi(a1s[e]) + w2 * bfhi(a2s[e]));
        }
        wr_.x = wrs[0]; wr_.y = wrs[1]; wr_.z = wrs[2]; wr_.w = wrs[3];
        wa_.x = was[0]; wa_.y = was[1]; wa_.z = was[2]; wa_.w = was[3];
        *(u32x4*)(rp) = wr_;
        *(u32x4*)(rp + 1024) = wa_;
    }
    __syncthreads();
}

__global__ void __launch_bounds__(NTHR, 2) fwd_megakernel(Args args) {
    extern __shared__ __attribute__((aligned(16))) unsigned char lds_raw[];
    cg::grid_group grid = cg::this_grid();
    LAS unsigned char* lds = (LAS unsigned char*)lds_raw;
    const int tid = threadIdx.x, lane = tid & 63, wave = __builtin_amdgcn_readfirstlane(tid >> 6);
    const int G = gridDim.x, bx = blockIdx.x;
    const int gw = bx * NWAVES + wave, ngw = G * NWAVES;
    unsigned char* ws = args.ws;
    if (args.out == nullptr) grid.sync();
    volatile LAS unsigned* bst = (volatile LAS unsigned*)(lds + 131072 + 64);
    if (tid < 2) bst[tid] = 0u;
    __syncthreads();
    const XcdBarrier gbar = xcd_barrier_post((unsigned*)(ws + WS_BAR), bst);
    const float* x = args.in[0]; const float* w_in = args.in[1]; const float* w_pa = args.in[2]; const float* w_pr = args.in[3]; const float* w_o = args.in[4];
    const float* lbraw = args.in[5]; const float* hgain = args.in[6]; const float* g_pre = args.in[7]; const float* g_post = args.in[8];
    const float* w_gu = args.in[9]; const float* w_dn = args.in[10]; const float* g_fpre = args.in[11]; const float* g_fpost = args.in[12];
    float* out = args.out;
    float* LB = (float*)(ws + WS_LB); float* LSE = (float*)(ws + WS_LSE); float* DEC = (float*)(ws + WS_DEC); float* ROPE = (float*)(ws + WS_ROPE);
    bf16_t* WIN_T = (bf16_t*)(ws + WS_WIN); bf16_t* XN = (bf16_t*)(ws + WS_XN); bf16_t* Qb = (bf16_t*)(ws + WS_Q); bf16_t* Kb = (bf16_t*)(ws + WS_K); bf16_t* Vb = (bf16_t*)(ws + WS_V);
    bf16_t* Sb = (bf16_t*)(ws + WS_S); bf16_t* HG = (bf16_t*)out;
    bf16_t* WPA_T = (bf16_t*)(ws + WS_WPA); bf16_t* WPR_T = (bf16_t*)(ws + WS_WPR); bf16_t* WO_T = (bf16_t*)(ws + WS_WO); bf16_t* WDN_T = (bf16_t*)(ws + WS_WDN);
    bf16_t* WGU_T = (bf16_t*)(ws + WS_WGU); bf16_t* Gt = (bf16_t*)(ws + WS_G); bf16_t* Yb = (bf16_t*)(ws + WS_Y); bf16_t* Z = (bf16_t*)(ws + WS_Z);
    bf16_t* A2 = (bf16_t*)(ws + WS_A2); bf16_t* FFH = (bf16_t*)(ws + WS_FFH); bf16_t* Z2 = (bf16_t*)(ws + WS_Z2);
    float* RSTD0 = (float*)(ws + WS_RSTD0); float* R2 = (float*)(ws + WS_R2);
    bf16_t* H1B = (bf16_t*)(ws + WS_Y);

    transpose_all<1>(w_in, DM, NIN, WIN_T, lds, gw, ngw, wave, lane);
    {
    f32x4 gpre[8];
#pragma unroll
    for (int j = 0; j < 8; ++j) gpre[j] = ((const f32x4*)g_pre)[128 * (j >> 1) + 2 * lane + (j & 1)];
    for (int row = gw; row < MTOK; row += ngw) {
        const f32x4* xr = (const f32x4*)(x + (size_t)row * DM) + 2 * lane;
        f32x4 v[8]; float s = 0.f;
#pragma unroll
        for (int j = 0; j < 8; ++j) { v[j] = xr[128 * (j >> 1) + (j & 1)]; s += (v[j][0] * v[j][0] + v[j][1] * v[j][1]) + (v[j][2] * v[j][2] + v[j][3] * v[j][3]); }
        const float rstd = rsqrtf(wave_sum(s) * (1.f / DM) + EPS);
        if (lane == 0) RSTD0[row] = rstd;
        u32x4* o16 = (u32x4*)(XN + (size_t)row * DM) + lane;
#pragma unroll
        for (int jj = 0; jj < 4; ++jj) { const f32x4 g0 = gpre[2 * jj], g1 = gpre[2 * jj + 1], p = v[2 * jj], q = v[2 * jj + 1]; u32x4 w;
            w.x = cvtpk(p[0] * rstd * g0[0], p[1] * rstd * g0[1]); w.y = cvtpk(p[2] * rstd * g0[2], p[3] * rstd * g0[3]);
            w.z = cvtpk(q[0] * rstd * g1[0], q[1] * rstd * g1[1]); w.w = cvtpk(q[2] * rstd * g1[2], q[3] * rstd * g1[3]); o16[64 * jj] = w; }
    }
    }
    if (bx == 0 && tid < 64) ROPE[tid] = args.inv_freq[tid];
    if (bx == 0) for (int j = tid; j < 1024; j += NTHR) LB[j] = 1.f / (1.f + __expf(lbraw[1024 + j] - lbraw[j]));
    xcd_barrier(gbar);

    {
        pg8::Gemm g{XN, WIN_T, MTOK, 13312, DM, DM, DM}; pg8::StaticOrder S; S.init(MTOK, 13312, G, bx);
        pg8::EpiProj E{Qb, Kb, Vb, HG, ROPE};
        pg8::gemm_phase<pg8::EpiProj, pg8::StaticOrder, true, true>(lds, g, S, E);
    }
    xcd_barrier(gbar);

    {
        const int vcu = ((G & 7) == 0) ? (bx & 7) * (G >> 3) + (bx >> 3) : bx;
        for (int a = vcu; a < 3072; a += G) attn_unit(lds, a, Qb, Kb, Vb, Qb, LSE);
    }
    for (int u = bx; u < 2048; u += G) hgrn_pass_a(lds, u, HG, LB, Sb, DEC);
    xcd_barrier(gbar);

    for (int idx = bx * NTHR + tid; idx < 16 * 8192; idx += G * NTHR) {
        const int bh = idx >> 13, e2 = idx & 8191;
        unsigned* sp = (unsigned*)(Sb + (size_t)bh * 128 * 16384) + e2;
        const float* dp = DEC + (size_t)bh * 128 * 128 + ((2 * e2) & 127);
        float c0 = 0.f, c1 = 0.f;
        for (int cb = 0; cb < 128; cb += 16) {
            unsigned wv[16]; float d0v[16], d1v[16];
#pragma unroll
            for (int c = 0; c < 16; ++c) { wv[c] = sp[(size_t)(cb + c) * 8192]; d0v[c] = dp[(cb + c) * 128]; d1v[c] = dp[(cb + c) * 128 + 1]; }
#pragma unroll
            for (int c = 0; c < 16; ++c) { const unsigned w = wv[c]; wv[c] = cvtpk(c0, c1); c0 = d0v[c] * c0 + bflo(w); c1 = d1v[c] * c1 + bfhi(w); }
#pragma unroll
            for (int c = 0; c < 16; ++c) sp[(size_t)(cb + c) * 8192] = wv[c];
        }
    }
    transpose_all<0>(w_pa, 1024, DM, WPA_T, lds, gw, ngw, wave, lane);
    transpose_all<0>(w_pr, 1024, DM, WPR_T, lds, gw, ngw, wave, lane);
    transpose_all<0>(w_o, DM, DM, WO_T, lds, gw, ngw, wave, lane);
    transpose_all<0>(w_dn, DFF, DM, WDN_T, lds, gw, ngw, wave, lane);
    transpose_all<2>(w_gu, DM, 2 * DFF, WGU_T, lds, gw, ngw, wave, lane, g_fpre);
    __syncthreads();
    {
        pg8::Gemm g{XN, (const bf16_t*)(ws + WS_WING), MTOK, 4096, DM, DM, DM}; pg8::StaticOrder S; S.init(MTOK, 4096, G, bx);
        pg8::EpiPlain E{Gt, 4096};
        pg8::gemm_phase<pg8::EpiPlain, pg8::StaticOrder, true, true>(lds, g, S, E);
    }
    xcd_barrier(gbar);

    for (int u = bx; u < 2048; u += G) hgrn_pass_c(lds, u, HG, LB, Sb, hgain, Qb, LSE);
    xcd_barrier(gbar);

    {
        pg8::PairOrder S; S.init(MTOK, DM, G, bx); S.A20 = HG + 1024; S.A21 = HG; S.B20 = WPA_T; S.B21 = WPR_T;
        pg8::Gemm g{HG, WPA_T, MTOK, DM, 1024, 4096, 1024};
        pg8::EpiGate2 E{Yb, Gt};
        pg8::gemm_phase<pg8::EpiGate2, pg8::PairOrder, true, true>(lds, g, S, E);
    }
    xcd_barrier(gbar);

    {
        pg8::Gemm g{Yb, WO_T, MTOK, DM, DM, DM, DM}; pg8::StaticOrder S; S.init(MTOK, DM, G, bx);
        pg8::EpiPlain E{Z, DM};
        pg8::gemm_phase<pg8::EpiPlain, pg8::StaticOrder, true, true>(lds, g, S, E);
    }
    xcd_barrier(gbar);

    {
    int lane = threadIdx.x & 63; asm volatile("" : "+v"(lane));
    int gw = bx * NWAVES + __builtin_amdgcn_readfirstlane(threadIdx.x >> 6); asm volatile("" : "+s"(gw));
    f32x4 gpo[8], igp[8];
#pragma unroll
    for (int j = 0; j < 8; ++j) { const int gi = 128 * (j >> 1) + 2 * lane + (j & 1); gpo[j] = ((const f32x4*)g_post)[gi];
        const f32x4 gq = ((const f32x4*)g_pre)[gi]; igp[j] = (f32x4){1.f / gq[0], 1.f / gq[1], 1.f / gq[2], 1.f / gq[3]}; }
    for (int row = gw; row < MTOK; row += ngw) {
        const u32x4* zr = (const u32x4*)(Z + (size_t)row * DM) + lane; const u32x4* xr = (const u32x4*)(XN + (size_t)row * DM) + lane;
        const float ir0 = 1.f / RSTD0[row];
        u32x4 zq[4], xq[4];
#pragma unroll
        for (int jj = 0; jj < 4; ++jj) { zq[jj] = zr[64 * jj]; xq[jj] = xr[64 * jj]; }
        f32x4 v[8], xv8[8]; float s = 0.f;
#pragma unroll
        for (int j = 0; j < 8; ++j) { const unsigned z0 = (j & 1) ? zq[j >> 1].z : zq[j >> 1].x, z1 = (j & 1) ? zq[j >> 1].w : zq[j >> 1].y;
            const unsigned x0 = (j & 1) ? xq[j >> 1].z : xq[j >> 1].x, x1 = (j & 1) ? xq[j >> 1].w : xq[j >> 1].y;
            v[j] = (f32x4){bflo(z0), bfhi(z0), bflo(z1), bfhi(z1)};
            xv8[j] = (f32x4){bflo(x0) * ir0 * igp[j][0], bfhi(x0) * ir0 * igp[j][1], bflo(x1) * ir0 * igp[j][2], bfhi(x1) * ir0 * igp[j][3]};
            s += (v[j][0] * v[j][0] + v[j][1] * v[j][1]) + (v[j][2] * v[j][2] + v[j][3] * v[j][3]); }
        const float r1 = rsqrtf(wave_sum(s) * (1.f / DM) + EPS);
        float s2 = 0.f;
#pragma unroll
        for (int j = 0; j < 8; ++j) { const f32x4 gg = gpo[j]; const f32x4 xv = xv8[j]; f32x4 hv;
            hv[0] = xv[0] + v[j][0] * r1 * gg[0]; hv[1] = xv[1] + v[j][1] * r1 * gg[1]; hv[2] = xv[2] + v[j][2] * r1 * gg[2]; hv[3] = xv[3] + v[j][3] * r1 * gg[3];
            v[j] = hv; s2 += (hv[0] * hv[0] + hv[1] * hv[1]) + (hv[2] * hv[2] + hv[3] * hv[3]); }
        const float r2 = rsqrtf(wave_sum(s2) * (1.f / DM) + EPS);
        if (lane == 0) R2[row] = r2;
        u32x4* h16 = (u32x4*)(H1B + (size_t)row * DM) + lane;
#pragma unroll
        for (int jj = 0; jj < 4; ++jj) { const f32x4 p = v[2 * jj], q = v[2 * jj + 1]; u32x4 hw;
            hw.x = cvtpk(p[0], p[1]); hw.y = cvtpk(p[2], p[3]); hw.z = cvtpk(q[0], q[1]); hw.w = cvtpk(q[2], q[3]); h16[64 * jj] = hw; }
    }
    }
    xcd_barrier(gbar);

    {
        pg8::Gemm g{H1B, WGU_T, MTOK, 2 * DFF, DM, DM, DM}; pg8::StaticOrder S; S.init(MTOK, 2 * DFF, G, bx);
        pg8::EpiSwiGLU E{FFH, DFF, R2};
        pg8::gemm_phase<pg8::EpiSwiGLU, pg8::StaticOrder, true, true>(lds, g, S, E);
    }
    xcd_barrier(gbar);

    {
        pg8::Gemm g{FFH, WDN_T, MTOK, DM, DFF, DFF, DFF}; pg8::StaticOrder S; S.init(MTOK, DM, G, bx);
        pg8::EpiPlain E{Z2, DM};
        pg8::gemm_phase<pg8::EpiPlain, pg8::StaticOrder, true, true>(lds, g, S, E);
    }
    xcd_barrier(gbar);

    {
    int lane = threadIdx.x & 63; asm volatile("" : "+v"(lane));
    int gw = bx * NWAVES + __builtin_amdgcn_readfirstlane(threadIdx.x >> 6); asm volatile("" : "+s"(gw));
    f32x4 gfo[8];
#pragma unroll
    for (int j = 0; j < 8; ++j) gfo[j] = ((const f32x4*)g_fpost)[128 * (j >> 1) + 2 * lane + (j & 1)];
    for (int row = gw; row < MTOK; row += ngw) {
        const u32x4* zr = (const u32x4*)(Z2 + (size_t)row * DM) + lane; const u32x4* hr = (const u32x4*)(H1B + (size_t)row * DM) + lane;
        f32x4* orow = (f32x4*)(out + (size_t)row * DM) + 2 * lane;
        u32x4 zq[4], hq[4];
#pragma unroll
        for (int jj = 0; jj < 4; ++jj) { zq[jj] = zr[64 * jj]; hq[jj] = hr[64 * jj]; }
        f32x4 v[8]; float s = 0.f;
#pragma unroll
        for (int j = 0; j < 8; ++j) { const unsigned z0 = (j & 1) ? zq[j >> 1].z : zq[j >> 1].x, z1 = (j & 1) ? zq[j >> 1].w : zq[j >> 1].y;
            v[j] = (f32x4){bflo(z0), bfhi(z0), bflo(z1), bfhi(z1)}; s += (v[j][0] * v[j][0] + v[j][1] * v[j][1]) + (v[j][2] * v[j][2] + v[j][3] * v[j][3]); }
        const float r1 = rsqrtf(wave_sum(s) * (1.f / DM) + EPS);
#pragma unroll
        for (int j = 0; j < 8; ++j) { const f32x4 gg = gfo[j]; const unsigned h0 = (j & 1) ? hq[j >> 1].z : hq[j >> 1].x, h1_ = (j & 1) ? hq[j >> 1].w : hq[j >> 1].y;
            f32x4 hv = (f32x4){bflo(h0), bfhi(h0), bflo(h1_), bfhi(h1_)};
            hv[0] += v[j][0] * r1 * gg[0]; hv[1] += v[j][1] * r1 * gg[1]; hv[2] += v[j][2] * r1 * gg[2]; hv[3] += v[j][3] * r1 * gg[3]; __builtin_nontemporal_store(hv, &orow[128 * (j >> 1) + (j & 1)]); }
    }
    }
}

extern "C" void kernel_launch(void* const* d_in, const int* in_sizes, int n_in, void* d_out, int out_size, void* d_ws, size_t ws_size, hipStream_t stream) {
    static int grid = 0;
    if (grid == 0) {
        if (n_in != 13 || out_size != MTOK * DM || ws_size < WS_END) { fprintf(stderr, "kernel_launch: unexpected shapes (n_in %d out %d ws %zu)\n", n_in, out_size, ws_size); grid = -1; return; }
        int dev = 0, cus = 0, per_cu = 0;
        hipGetDevice(&dev); hipDeviceGetAttribute(&cus, hipDeviceAttributeMultiprocessorCount, dev);
        hipFuncSetAttribute((const void*)fwd_megakernel, hipFuncAttributeMaxDynamicSharedMemorySize, LDS_BYTES);
        hipOccupancyMaxActiveBlocksPerMultiprocessor(&per_cu, (const void*)fwd_megakernel, NTHR, LDS_BYTES);
        if (per_cu < 1) per_cu = 1;
        (void)hipGetLastError();
        grid = cus;
    }
    if (grid < 0) return;
    Args a{};
    for (int i = 0; i < 13; ++i) a.in[i] = (const float*)d_in[i];
    a.out = (float*)d_out; a.ws = (unsigned char*)d_ws;
    for (int i = 0; i < 64; ++i) a.inv_freq[i] = (float)pow(10000.0, -(double)(2 * i) / 128.0);
    (void)hipMemsetAsync((unsigned char*)d_ws + WS_BAR, 0, WS_BAR_BYTES, stream);
    void* kargs[] = {&a};
    hipError_t e = hipLaunchCooperativeKernel((const void*)fwd_megakernel, dim3(grid), dim3(NTHR), kargs, LDS_BYTES, stream);
    if (e != hipSuccess) fprintf(stderr, "cooperative launch failed: %s (grid %d)\n", hipGetErrorString(e), grid);
}
```

```cpp
#include <hip/hip_runtime.h>
#include <hip/hip_cooperative_groups.h>
#include <cstdio>
#include <cstdint>
#include <cmath>
namespace cg = cooperative_groups;

namespace pg8 {
#define PG8_LAS __attribute__((address_space(3)))
typedef unsigned short bf16_t;
typedef short bf16x8 __attribute__((ext_vector_type(8)));
typedef float f32x4 __attribute__((ext_vector_type(4)));
typedef unsigned u32x4 __attribute__((ext_vector_type(4)));
typedef unsigned u32x2 __attribute__((ext_vector_type(2)));
constexpr int BM = 256, BK = 64, HALF = 128, HTB = HALF * BK * 2, STAGE_BYTES = 8 * HTB, NXCD = 8, WGM = 4;

__host__ __device__ __forceinline__ int lds_byte(int r, int c) { const int st = (r >> 4) * 2 + (c >> 5), rr = r & 15, cc = c & 31, ob = rr * 64 + cc * 2; return st * 1024 + (ob ^ (((ob >> 9) & 1) << 5)); }
__host__ __device__ __forceinline__ void stage_rc(int b, int& R, int& C) { const int st = b / 1024, sb = b % 1024, swz = sb ^ (((sb >> 9) & 1) << 5); R = (st >> 1) * 16 + swz / 64; C = (st & 1) * 32 + (swz % 64) / 2; }
__host__ __device__ __forceinline__ int perm32(int rho) { const int n = rho >> 4, i = rho & 15; return 8 * (i >> 2) + 4 * n + (i & 3); }

struct Unit { int pm, pn, half; };
struct Gemm { const bf16_t* A; const bf16_t* Bt; int M, N, K, lda, ldb; };

struct StaticOrder {
    int nM, nN, nwg, G, c;
    __host__ __device__ void init(int M, int N, int G_, int c_) { nM = M / BM; nN = N / BM; nwg = nM * nN; G = G_; c = c_; }
    __host__ __device__ bool next(int i, Unit& u) const {
        const long L = (long)i * G + c; if (L >= nwg) return false;
        int wgid = (int)L; const int xcd_ = wgid % NXCD; { const int q = nwg / NXCD, r = nwg % NXCD, xcd = wgid % NXCD, off = wgid / NXCD; wgid = (xcd < r ? xcd * (q + 1) : r * (q + 1) + (xcd - r) * q) + off; }
        const int nig = WGM * nN, gid = wgid / nig, fm = gid * WGM, gsz = (nM - fm) < WGM ? (nM - fm) : WGM;
        u.pm = fm + ((wgid % nig) % gsz); u.pn = ((wgid % nig) / gsz + xcd_ * (nN / NXCD)) % nN; u.half = 0; return true;
    }
    __device__ __forceinline__ const char* baseA(const Gemm& g, const Unit&) const { return (const char*)g.A; }
    __device__ __forceinline__ const char* baseB(const Gemm& g, const Unit&) const { return (const char*)g.Bt; }
    __device__ __forceinline__ void a_ready(const Unit&) const {}
    __device__ __forceinline__ void done(const Unit&) const {}
};
struct PairOrder : StaticOrder {
    const bf16_t *A20, *A21, *B20, *B21;
    __device__ bool next(int i, Unit& u) const { const bool r = StaticOrder::next(i >> 1, u); u.half = i & 1; return r; }
    __device__ __forceinline__ const char* baseA(const Gemm&, const Unit& u) const { return (const char*)(u.half ? A21 : A20); }
    __device__ __forceinline__ const char* baseB(const Gemm&, const Unit& u) const { return (const char*)(u.half ? B21 : B20); }
};

typedef float f32x2_t __attribute__((ext_vector_type(2))); typedef __bf16 bf16x2_t __attribute__((ext_vector_type(2)));
__device__ __forceinline__ unsigned cvtpk(float lo, float hi) { f32x2_t v = {lo, hi}; bf16x2_t b = __builtin_convertvector(v, bf16x2_t); return __builtin_bit_cast(unsigned, b); }
__device__ __forceinline__ float bflo(unsigned w) { return __uint_as_float(w << 16); }
__device__ __forceinline__ float bfhi(unsigned w) { return __uint_as_float(w & 0xffff0000u); }
__device__ __forceinline__ float sigmoidf_(float x) { return __builtin_amdgcn_rcpf(1.f + __builtin_amdgcn_exp2f(-1.4426950408889634f * x)); }
__device__ __forceinline__ float siluf_(float x) { return x * sigmoidf_(x); }


constexpr float QSCALE = 0.08838834764831845f * 1.4426950408889634f;

struct EpiProj {
    static constexpr bool PERM = true, AFTER_DRAIN = false, TWO_STAGE = false;
    bf16_t *Q, *Kb, *V, *HG; const float* invf;
    __device__ __forceinline__ void operator()(const f32x4 (&acc)[2][2][4][2], const Unit& u, int wr, int wc, int fr, int fq) const {
        const int row0 = u.pm * BM + wr * 64 + fr;
        if (u.pn < 24) {
            const bool isq = u.pn < 12; bf16_t* base = isq ? Q : Kb; const int pnl = isq ? u.pn : u.pn - 12; const float sc = isq ? QSCALE : 1.f;
            const int head = 2 * pnl + (wc >> 1), d0 = 32 * (wc & 1) + 8 * fq;
            const f32x4 fa = *(const f32x4*)(invf + d0), fb = *(const f32x4*)(invf + d0 + 4);
            const float fe[8] = {fa[0], fa[1], fa[2], fa[3], fb[0], fb[1], fb[2], fb[3]};
#pragma unroll
            for (int ai = 0; ai < 2; ++ai)
#pragma unroll
                for (int m = 0; m < 4; ++m) {
                    const int row = row0 + ai * HALF + m * 16, pos = row & 8191;
                    const float posf = (float)pos;
                    const f32x4 l0 = acc[ai][0][m][0], l1 = acc[ai][0][m][1], h0 = acc[ai][1][m][0], h1 = acc[ai][1][m][1];
                    float lo[8] = {l0[0], l0[1], l0[2], l0[3], l1[0], l1[1], l1[2], l1[3]};
                    float hi[8] = {h0[0], h0[1], h0[2], h0[3], h1[0], h1[1], h1[2], h1[3]};
                    float cs[8], sn[8];
#pragma unroll
                    for (int e = 0; e < 8; ++e) {
                        const float ang = posf * fe[e];
                        const float kq = __builtin_rintf(ang * 0.15915494309189535f);
                        float rr = __builtin_fmaf(-kq, 6.28125f, ang); rr = __builtin_fmaf(-kq, 1.9353071795864769e-3f, rr);
                        const float tt = rr * 0.15915494309189535f;
                        cs[e] = __builtin_amdgcn_cosf(tt); sn[e] = __builtin_amdgcn_sinf(tt);
                    }
                    float ol[8], oh[8];
#pragma unroll
                    for (int e = 0; e < 8; ++e) { ol[e] = (lo[e] * cs[e] - hi[e] * sn[e]) * sc; oh[e] = (hi[e] * cs[e] + lo[e] * sn[e]) * sc; }
                    bf16_t* rowp = base + (size_t)row * 3072 + head * 128 + d0;
                    u32x4 w; w.x = cvtpk(ol[0], ol[1]); w.y = cvtpk(ol[2], ol[3]); w.z = cvtpk(ol[4], ol[5]); w.w = cvtpk(ol[6], ol[7]);
                    *(u32x4*)rowp = w;
                    w.x = cvtpk(oh[0], oh[1]); w.y = cvtpk(oh[2], oh[3]); w.z = cvtpk(oh[4], oh[5]); w.w = cvtpk(oh[6], oh[7]);
                    *(u32x4*)(rowp + 64) = w;
                }
        } else {
            bf16_t* base; int ldc, colt;
            if (u.pn < 36) { base = V; ldc = 3072; colt = (u.pn - 24) * BM; } else { base = HG; ldc = 4096; colt = (u.pn - 36) * BM; }
            const int col0 = colt + wc * 32 + 8 * fq;
#pragma unroll
            for (int ai = 0; ai < 2; ++ai)
#pragma unroll
                for (int m = 0; m < 4; ++m) { bf16_t* rowp = base + (size_t)(row0 + ai * HALF + m * 16) * ldc + col0;
#pragma unroll
                    for (int bj = 0; bj < 2; ++bj) { const f32x4 v0 = acc[ai][bj][m][0], v1 = acc[ai][bj][m][1];
                        u32x4 w; w.x = cvtpk(v0[0], v0[1]); w.y = cvtpk(v0[2], v0[3]); w.z = cvtpk(v1[0], v1[1]); w.w = cvtpk(v1[2], v1[3]);
                        *(u32x4*)(rowp + bj * HALF) = w; } }
        }
    }
};
struct EpiPlain {
    static constexpr bool PERM = true, AFTER_DRAIN = false, TWO_STAGE = false;
    bf16_t* O; int ldc;
    __device__ __forceinline__ void operator()(const f32x4 (&acc)[2][2][4][2], const Unit& u, int wr, int wc, int fr, int fq) const {
        const int row0 = u.pm * BM + wr * 64 + fr, col0 = u.pn * BM + wc * 32 + 8 * fq;
#pragma unroll
        for (int ai = 0; ai < 2; ++ai)
#pragma unroll
            for (int m = 0; m < 4; ++m) { bf16_t* rowp = O + (size_t)(row0 + ai * HALF + m * 16) * ldc + col0;
#pragma unroll
                for (int bj = 0; bj < 2; ++bj) { const f32x4 v0 = acc[ai][bj][m][0], v1 = acc[ai][bj][m][1];
                    u32x4 w; w.x = cvtpk(v0[0], v0[1]); w.y = cvtpk(v0[2], v0[3]); w.z = cvtpk(v1[0], v1[1]); w.w = cvtpk(v1[2], v1[3]);
                    *(u32x4*)(rowp + bj * HALF) = w; } }
    }
};
template <bool ACCUM> struct EpiGate {
    static constexpr bool PERM = true, AFTER_DRAIN = false, TWO_STAGE = false;
    bf16_t* Y; const bf16_t* G; int goff;
    __device__ __forceinline__ void operator()(const f32x4 (&acc)[2][2][4][2], const Unit& u, int wr, int wc, int fr, int fq) const {
        const int row0 = u.pm * BM + wr * 64 + fr, col0 = u.pn * BM + wc * 32 + 8 * fq;
#pragma unroll
        for (int ai = 0; ai < 2; ++ai) {
            u32x4 gwv[4][2], ywv[4][2];
#pragma unroll
            for (int m = 0; m < 4; ++m)
#pragma unroll
                for (int bj = 0; bj < 2; ++bj) { const size_t row = (size_t)(row0 + ai * HALF + m * 16);
                    gwv[m][bj] = *(const u32x4*)(G + row * 4096 + goff + col0 + bj * HALF);
                    if (ACCUM) ywv[m][bj] = *(const u32x4*)(Y + row * 2048 + col0 + bj * HALF); }
#pragma unroll
            for (int m = 0; m < 4; ++m) { const size_t row = (size_t)(row0 + ai * HALF + m * 16);
#pragma unroll
                for (int bj = 0; bj < 2; ++bj) {
                    const u32x4 gw = gwv[m][bj];
                    bf16_t* yp = Y + row * 2048 + col0 + bj * HALF;
                    const f32x4 v0 = acc[ai][bj][m][0], v1 = acc[ai][bj][m][1];
                    float o[8] = {v0[0], v0[1], v0[2], v0[3], v1[0], v1[1], v1[2], v1[3]};
                    const unsigned gws[4] = {gw.x, gw.y, gw.z, gw.w};
#pragma unroll
                    for (int e = 0; e < 4; ++e) { o[2 * e] *= sigmoidf_(bflo(gws[e])); o[2 * e + 1] *= sigmoidf_(bfhi(gws[e])); }
                    if (ACCUM) { const u32x4 yw = ywv[m][bj]; const unsigned yws[4] = {yw.x, yw.y, yw.z, yw.w};
#pragma unroll
                        for (int e = 0; e < 4; ++e) { o[2 * e] += bflo(yws[e]); o[2 * e + 1] += bfhi(yws[e]); } }
                    u32x4 w; w.x = cvtpk(o[0], o[1]); w.y = cvtpk(o[2], o[3]); w.z = cvtpk(o[4], o[5]); w.w = cvtpk(o[6], o[7]);
                    *(u32x4*)yp = w; } }
        }
    }
};
struct EpiGate2 {
    static constexpr bool PERM = true, AFTER_DRAIN = false, TWO_STAGE = true;
    bf16_t* Y; const bf16_t* G;
    __device__ __forceinline__ void mid(f32x4 (&acc)[2][2][4][2], const Unit& u, int wr, int wc, int fr, int fq) const {
        const int row0 = u.pm * BM + wr * 64 + fr, col0 = u.pn * BM + wc * 32 + 8 * fq;
#pragma unroll
        for (int ai = 0; ai < 2; ++ai) {
            u32x4 gav[4][2], grv[4][2];
#pragma unroll
            for (int m = 0; m < 4; ++m)
#pragma unroll
                for (int bj = 0; bj < 2; ++bj) { const bf16_t* gp = G + (size_t)(row0 + ai * HALF + m * 16) * 4096 + col0 + bj * HALF;
                    gav[m][bj] = *(const u32x4*)gp; grv[m][bj] = *(const u32x4*)(gp + 2048); }
#pragma unroll
            for (int m = 0; m < 4; ++m)
#pragma unroll
                for (int bj = 0; bj < 2; ++bj) {
                    const unsigned gas[4] = {gav[m][bj].x, gav[m][bj].y, gav[m][bj].z, gav[m][bj].w}, grs[4] = {grv[m][bj].x, grv[m][bj].y, grv[m][bj].z, grv[m][bj].w};
#pragma unroll
                    for (int e = 0; e < 4; ++e) {
                        const float ea0 = __builtin_amdgcn_exp2f(-1.4426950408889634f * bflo(gas[e])), ea1 = __builtin_amdgcn_exp2f(-1.4426950408889634f * bfhi(gas[e]));
                        const float er0 = __builtin_amdgcn_exp2f(-1.4426950408889634f * bflo(grs[e])), er1 = __builtin_amdgcn_exp2f(-1.4426950408889634f * bfhi(grs[e]));
                        const float r0 = (1.f + er0) * __builtin_amdgcn_rcpf(1.f + ea0), r1 = (1.f + er1) * __builtin_amdgcn_rcpf(1.f + ea1);
                        acc[ai][bj][m][e >> 1][(2 * e) & 3] *= r0; acc[ai][bj][m][e >> 1][(2 * e + 1) & 3] *= r1;
                    }
                }
        }
    }
    __device__ __forceinline__ void operator()(const f32x4 (&acc)[2][2][4][2], const Unit& u, int wr, int wc, int fr, int fq) const {
        const int row0 = u.pm * BM + wr * 64 + fr, col0 = u.pn * BM + wc * 32 + 8 * fq;
#pragma unroll
        for (int ai = 0; ai < 2; ++ai) {
            u32x4 grv[4][2];
#pragma unroll
            for (int m = 0; m < 4; ++m)
#pragma unroll
                for (int bj = 0; bj < 2; ++bj) grv[m][bj] = *(const u32x4*)(G + (size_t)(row0 + ai * HALF + m * 16) * 4096 + 2048 + col0 + bj * HALF);
#pragma unroll
            for (int m = 0; m < 4; ++m)
#pragma unroll
                for (int bj = 0; bj < 2; ++bj) {
                    const f32x4 v0 = acc[ai][bj][m][0], v1 = acc[ai][bj][m][1];
                    float o[8] = {v0[0], v0[1], v0[2], v0[3], v1[0], v1[1], v1[2], v1[3]};
                    const unsigned grs[4] = {grv[m][bj].x, grv[m][bj].y, grv[m][bj].z, grv[m][bj].w};
#pragma unroll
                    for (int e = 0; e < 4; ++e) { o[2 * e] *= sigmoidf_(bflo(grs[e])); o[2 * e + 1] *= sigmoidf_(bfhi(grs[e])); }
                    u32x4 w; w.x = cvtpk(o[0], o[1]); w.y = cvtpk(o[2], o[3]); w.z = cvtpk(o[4], o[5]); w.w = cvtpk(o[6], o[7]);
                    *(u32x4*)(Y + (size_t)(row0 + ai * HALF + m * 16) * 2048 + col0 + bj * HALF) = w;
                }
        }
    }
};
struct EpiF32 {
    static constexpr bool PERM = false, AFTER_DRAIN = false, TWO_STAGE = false;
    float* O; int ldc;
    __device__ __forceinline__ void operator()(const f32x4 (&acc)[2][2][4][2], const Unit& u, int wr, int wc, int fr, int fq) const {
        const int row0 = u.pm * BM + wr * 64 + fr, col0 = u.pn * BM + wc * 32 + 4 * fq;
#pragma unroll
        for (int ai = 0; ai < 2; ++ai)
#pragma unroll
            for (int m = 0; m < 4; ++m) { float* rowp = O + (size_t)(row0 + ai * HALF + m * 16) * ldc + col0;
#pragma unroll
                for (int bj = 0; bj < 2; ++bj)
#pragma unroll
                    for (int n = 0; n < 2; ++n) *(f32x4*)(rowp + bj * HALF + n * 16) = acc[ai][bj][m][n]; }
    }
};
struct EpiSwiGLU {
    static constexpr bool PERM = true, AFTER_DRAIN = false, TWO_STAGE = false;
    bf16_t* O; int ldc; const float* rs;
    __device__ __forceinline__ void operator()(const f32x4 (&acc)[2][2][4][2], const Unit& u, int wr, int wc, int fr, int fq) const {
        const int row0 = u.pm * BM + wr * 64 + fr, col0 = u.pn * HALF + wc * 32 + 8 * fq;
        float rr[2][4];
#pragma unroll
        for (int ai = 0; ai < 2; ++ai)
#pragma unroll
            for (int m = 0; m < 4; ++m) rr[ai][m] = rs[row0 + ai * HALF + m * 16];
#pragma unroll
        for (int ai = 0; ai < 2; ++ai)
#pragma unroll
            for (int m = 0; m < 4; ++m) { bf16_t* rowp = O + (size_t)(row0 + ai * HALF + m * 16) * ldc + col0; const float r_ = rr[ai][m];
                const f32x4 g0 = acc[ai][0][m][0] * r_, g1 = acc[ai][0][m][1] * r_, u0 = acc[ai][1][m][0] * r_, u1 = acc[ai][1][m][1] * r_;
                float o[8];
#pragma unroll
                for (int e = 0; e < 4; ++e) { o[e] = siluf_(g0[e]) * u0[e]; o[4 + e] = siluf_(g1[e]) * u1[e]; }
                u32x4 w; w.x = cvtpk(o[0], o[1]); w.y = cvtpk(o[2], o[3]); w.z = cvtpk(o[4], o[5]); w.w = cvtpk(o[6], o[7]);
                *(u32x4*)rowp = w; }
    }
};

template <class Epi, class Sched, bool ALIGN_EPI = false, bool SP2 = false>
__device__ __forceinline__ void gemm_phase(PG8_LAS unsigned char* lds, const Gemm g, const Sched& S, const Epi& E) {
    int tid_ = threadIdx.x; asm volatile("" : "+v"(tid_));
    const int tid = tid_, wid = __builtin_amdgcn_readfirstlane(tid >> 6), lane = tid & 63, wr = wid >> 2, wc = wid & 3, fr = lane & 15, fq = lane >> 4;
    const int K = g.K, nt = K / BK;
    unsigned voffA[2], voffB[2];
#pragma unroll
    for (int i = 0; i < 2; ++i) { int R, C; stage_rc(tid * 16 + i * 8192, R, C); const int Rb = Epi::PERM ? ((R & ~31) + perm32(R & 31)) : R;
        voffA[i] = (unsigned)(R * g.lda + C) * 2u; voffB[i] = (unsigned)(Rb * g.ldb + C) * 2u; }
    const size_t kstep = (size_t)(BK * 2);
    const size_t hstepA = (size_t)HALF * g.lda * 2, hstepB = (size_t)HALF * g.ldb * 2;
    const size_t tstepA = 2 * hstepA, tstepB = 2 * hstepB;
    const unsigned ldsw = (unsigned)wid * 1024u;
    const int aoff = lds_byte(wr * 64 + fr, fq * 8), boff = lds_byte(wc * 32 + fr, fq * 8);
#define PG8_SA(b, h) (((b) * 2 + (h)) * HTB)
#define PG8_SB(b, h) ((4 + (b) * 2 + (h)) * HTB)
#define PG8_STAGE(bufoff, gbase, voff) do { _Pragma("unroll") for (int _i = 0; _i < 2; ++_i) \
        __builtin_amdgcn_global_load_lds((const unsigned*)((const char*)(gbase) + (voff)[_i]), (PG8_LAS unsigned*)(lds + (bufoff) + ldsw + _i * 8192), 16, 0, 0); } while (0)
#define PG8_LDA(dst, b, h) do { _Pragma("unroll") for (int m = 0; m < 4; ++m) _Pragma("unroll") for (int k = 0; k < 2; ++k) dst[m][k] = *(const PG8_LAS bf16x8*)(lds + PG8_SA(b, h) + aoff + m * 2048 + k * 1024); } while (0)
#define PG8_LDB(dst, b, h) do { _Pragma("unroll") for (int n = 0; n < 2; ++n) _Pragma("unroll") for (int k = 0; k < 2; ++k) dst[n][k] = *(const PG8_LAS bf16x8*)(lds + PG8_SB(b, h) + boff + n * 2048 + k * 1024); } while (0)
#define PG8_MMA(ai, bj, At, Bt) do { __builtin_amdgcn_s_setprio(1); _Pragma("unroll") for (int m = 0; m < 4; ++m) _Pragma("unroll") for (int n = 0; n < 2; ++n) _Pragma("unroll") for (int k = 0; k < 2; ++k) \
        acc[ai][bj][m][n] = __builtin_amdgcn_mfma_f32_16x16x32_bf16(Bt[n][k], At[m][k], acc[ai][bj][m][n], 0, 0, 0); __builtin_amdgcn_s_setprio(0); } while (0)
#define PG8_WAIT_V(n) asm volatile("s_waitcnt vmcnt(" #n ")" ::: "memory")
#define PG8_WAIT_L(n) asm volatile("s_waitcnt lgkmcnt(" #n ")" ::: "memory")
#define PG8_BAR __builtin_amdgcn_s_barrier()
#define PG8_SCHED __builtin_amdgcn_sched_barrier(0)
    Unit cur, nxt; int ui = 0;
    if (!S.next(0, cur)) return;
    f32x4 acc[2][2][4][2];
#pragma unroll
    for (int a = 0; a < 2; ++a)
#pragma unroll
        for (int b = 0; b < 2; ++b)
#pragma unroll
            for (int m = 0; m < 4; ++m)
#pragma unroll
                for (int n = 0; n < 2; ++n) acc[a][b][m][n] = (f32x4){0.f, 0.f, 0.f, 0.f};
    bf16x8 At[4][2], B0[2][2], B1[2][2];
    const char* cA = S.baseA(g, cur) + (size_t)cur.pm * tstepA; const char* cB = S.baseB(g, cur) + (size_t)cur.pn * tstepB;
    S.a_ready(cur);
    if constexpr (SP2) {
        PG8_STAGE(PG8_SB(0, 0), cB, voffB); PG8_STAGE(PG8_SB(0, 1), cB + hstepB, voffB); PG8_STAGE(PG8_SA(0, 0), cA, voffA); PG8_STAGE(PG8_SA(0, 1), cA + hstepA, voffA);
        if (wr == 1) PG8_BAR;
        PG8_WAIT_V(2); PG8_BAR;
        PG8_STAGE(PG8_SB(1, 0), cB + kstep, voffB); PG8_STAGE(PG8_SA(1, 0), cA + kstep, voffA); PG8_STAGE(PG8_SB(1, 1), cB + hstepB + kstep, voffB);
        PG8_WAIT_V(6); PG8_BAR;
    } else {
        PG8_STAGE(PG8_SB(0, 0), cB, voffB); PG8_STAGE(PG8_SA(0, 0), cA, voffA); PG8_STAGE(PG8_SB(0, 1), cB + hstepB, voffB); PG8_STAGE(PG8_SA(0, 1), cA + hstepA, voffA);
        if (wr == 1) PG8_BAR;
        PG8_WAIT_V(4); PG8_BAR;
        PG8_STAGE(PG8_SB(1, 0), cB + kstep, voffB); PG8_STAGE(PG8_SA(1, 0), cA + kstep, voffA); PG8_STAGE(PG8_SB(1, 1), cB + hstepB + kstep, voffB);
        PG8_WAIT_V(6); PG8_BAR;
    }
    for (;;) {
        const bool has_next = S.next(ui + 1, nxt);
        const char* nA = has_next ? S.baseA(g, nxt) + (size_t)nxt.pm * tstepA : cA; const char* nB = has_next ? S.baseB(g, nxt) + (size_t)nxt.pn * tstepB : cB;
        for (int t = 0; t < nt; t += 2) {
            const bool last = (t == nt - 2);
            const char* a1 = cA + (size_t)(t + 1) * kstep;
            const char* a2 = last ? nA : cA + (size_t)(t + 2) * kstep; const char* b2 = last ? nB : cB + (size_t)(t + 2) * kstep;
            const char* a3 = a2 + kstep; const char* b3 = b2 + kstep;
            if (last && has_next) S.a_ready(nxt);
            if constexpr (SP2) {
            PG8_LDB(B0, 0, 0); PG8_LDB(B1, 0, 1); PG8_SCHED; PG8_LDA(At, 0, 0); PG8_STAGE(PG8_SA(1, 1), a1 + hstepA, voffA);
            PG8_WAIT_V(8); PG8_WAIT_L(0); PG8_BAR; PG8_MMA(0, 0, At, B0); PG8_MMA(0, 1, At, B1); PG8_BAR; PG8_SCHED;
            PG8_LDA(At, 0, 1); PG8_STAGE(PG8_SB(0, 0), b2, voffB); PG8_STAGE(PG8_SB(0, 1), b2 + hstepB, voffB); PG8_STAGE(PG8_SA(0, 0), a2, voffA);
            PG8_WAIT_V(8); PG8_WAIT_L(0); PG8_BAR; PG8_MMA(1, 0, At, B0); PG8_MMA(1, 1, At, B1); PG8_BAR; PG8_SCHED;
            PG8_LDB(B0, 1, 0); PG8_LDB(B1, 1, 1); PG8_SCHED; PG8_LDA(At, 1, 0); PG8_STAGE(PG8_SA(0, 1), a2 + hstepA, voffA);
            PG8_WAIT_V(8); PG8_WAIT_L(0); PG8_BAR; PG8_MMA(0, 0, At, B0); PG8_MMA(0, 1, At, B1); PG8_BAR; PG8_SCHED;
            PG8_LDA(At, 1, 1); PG8_STAGE(PG8_SB(1, 0), b3, voffB); PG8_STAGE(PG8_SB(1, 1), b3 + hstepB, voffB); PG8_STAGE(PG8_SA(1, 0), a3, voffA);
            PG8_WAIT_V(8); PG8_WAIT_L(0); PG8_BAR; PG8_MMA(1, 0, At, B0); PG8_MMA(1, 1, At, B1); PG8_BAR; PG8_SCHED;
            } else {
            PG8_LDB(B0, 0, 0); PG8_SCHED; PG8_LDA(At, 0, 0); PG8_STAGE(PG8_SA(1, 1), a1 + hstepA, voffA);
            PG8_WAIT_L(8); PG8_BAR; PG8_WAIT_L(0); PG8_MMA(0, 0, At, B0); PG8_BAR; PG8_SCHED;
            PG8_LDB(B1, 0, 1); PG8_STAGE(PG8_SB(0, 0), b2, voffB);
            PG8_BAR; PG8_WAIT_L(0); PG8_MMA(0, 1, At, B1); PG8_BAR;
            PG8_LDA(At, 0, 1); PG8_STAGE(PG8_SA(0, 0), a2, voffA);
            PG8_BAR; PG8_WAIT_L(0); PG8_MMA(1, 0, At, B0); PG8_BAR; PG8_SCHED;
            PG8_STAGE(PG8_SB(0, 1), b2 + hstepB, voffB);
            PG8_WAIT_V(6); PG8_BAR; PG8_MMA(1, 1, At, B1); PG8_BAR;
            PG8_LDB(B0, 1, 0); PG8_SCHED; PG8_LDA(At, 1, 0); PG8_STAGE(PG8_SA(0, 1), a2 + hstepA, voffA);
            PG8_WAIT_L(8); PG8_BAR; PG8_WAIT_L(0); PG8_MMA(0, 0, At, B0); PG8_BAR; PG8_SCHED;
            PG8_LDB(B1, 1, 1); PG8_STAGE(PG8_SB(1, 0), b3, voffB);
            PG8_BAR; PG8_WAIT_L(0); PG8_MMA(0, 1, At, B1); PG8_BAR;
            PG8_LDA(At, 1, 1); PG8_STAGE(PG8_SA(1, 0), a3, voffA);
            PG8_BAR; PG8_WAIT_L(0); PG8_MMA(1, 0, At, B0); PG8_BAR; PG8_SCHED;
            PG8_STAGE(PG8_SB(1, 1), b3 + hstepB, voffB);
            PG8_WAIT_V(6); PG8_BAR; PG8_MMA(1, 1, At, B1); PG8_BAR;
            }
        }
        if constexpr (ALIGN_EPI) { if (wr == 0) PG8_BAR; }
        bool keep_acc = false;
        if constexpr (Epi::TWO_STAGE) { if (cur.half == 0) { E.mid(acc, cur, wr, wc, fr, fq); keep_acc = true; } else E(acc, cur, wr, wc, fr, fq); }
        else if constexpr (!Epi::AFTER_DRAIN) { E(acc, cur, wr, wc, fr, fq); S.done(cur); }
        if (!has_next) break;
        if (!keep_acc)
#pragma unroll
        for (int a = 0; a < 2; ++a)
#pragma unroll
            for (int b = 0; b < 2; ++b)
#pragma unroll
                for (int m = 0; m < 4; ++m)
#pragma unroll
                    for (int n = 0; n < 2; ++n) acc[a][b][m][n] = (f32x4){0.f, 0.f, 0.f, 0.f};
        cur = nxt; cA = nA; cB = nB; ++ui;
        if constexpr (ALIGN_EPI) { if (wr == 1) PG8_BAR; }
    }
    PG8_WAIT_V(0);
    if constexpr (!ALIGN_EPI) { if (wr == 0) PG8_BAR; }
    PG8_BAR;
#undef PG8_SA
#undef PG8_SB
#undef PG8_STAGE
#undef PG8_LDA
#undef PG8_LDB
#undef PG8_MMA
#undef PG8_WAIT_V
#undef PG8_WAIT_L
#undef PG8_BAR
#undef PG8_SCHED
}
}

using pg8::bf16_t; using pg8::bf16x8; using pg8::f32x4; using pg8::u32x4; using pg8::u32x2; using pg8::cvtpk; using pg8::bflo; using pg8::bfhi; using pg8::sigmoidf_; using pg8::siluf_;
typedef float f32x16 __attribute__((ext_vector_type(16)));
typedef short s16x4 __attribute__((ext_vector_type(4)));
typedef short v4i16_t __attribute__((ext_vector_type(4)));
#define LAS __attribute__((address_space(3)))
#define MFMA32(a, b, c) __builtin_amdgcn_mfma_f32_32x32x16_bf16((a), (b), (c), 0, 0, 0)

constexpr int NWAVES = 8, NTHR = 512;
constexpr int MTOK = 16384, DM = 2048, SEQ = 8192, DFF = 5632, NIN = 17408;
constexpr float EPS = 1e-6f;
constexpr size_t MiB = 1u << 20;
constexpr size_t WS_BAR = 65536, WS_BAR_BYTES = 16384;
constexpr size_t WS_R2 = 327680;
constexpr size_t WS_RSTD0 = 262144;
constexpr size_t WS_LB = 0, WS_LSE = 1 * MiB, WS_DEC = 3 * MiB, WS_ROPE = 4 * MiB, WS_WIN = 8 * MiB, WS_XN = 76 * MiB, WS_Q = 140 * MiB, WS_K = 236 * MiB, WS_V = 332 * MiB, WS_S = 428 * MiB;
constexpr size_t WS_WPA = 8 * MiB, WS_WPR = 12 * MiB, WS_WO = 16 * MiB, WS_WDN = 24 * MiB;
constexpr size_t WS_WING = WS_WIN + (size_t)13312 * 2048 * 2;
constexpr size_t WS_G = 236 * MiB, WS_WGU = 364 * MiB;
constexpr size_t WS_Y = WS_S, WS_Z = 236 * MiB, WS_A2 = WS_XN, WS_FFH = 140 * MiB, WS_Z2 = 316 * MiB;
constexpr size_t WS_END = 492 * MiB;
constexpr int LDS_BYTES = 147456;

struct Args { const float* in[13]; float* out; unsigned char* ws; float inv_freq[64]; };

__device__ __forceinline__ int crow(int reg, int h) { return (reg & 3) + 8 * (reg >> 2) + 4 * h; }
__device__ __forceinline__ float wave_sum(float v) {
#pragma unroll
    for (int o = 1; o < 64; o <<= 1) v += __shfl_xor(v, o);
    return v;
}
__device__ __forceinline__ bf16x8 pack8(const f32x16& x, int s8) {
    u32x4 p; p.x = cvtpk(x[s8 + 0], x[s8 + 1]); p.y = cvtpk(x[s8 + 2], x[s8 + 3]); p.z = cvtpk(x[s8 + 4], x[s8 + 5]); p.w = cvtpk(x[s8 + 6], x[s8 + 7]);
    return __builtin_bit_cast(bf16x8, p);
}
__device__ __forceinline__ s16x4 trd(const LAS unsigned char* p) { return __builtin_bit_cast(s16x4, __builtin_amdgcn_ds_read_tr16_b64_v4i16((LAS v4i16_t*)p)); }


#define XB_TMO      128
#define XB_XCNT(j)  (256  + 64 * (j))
#define XB_XSUB(j)  (1280 + 64 * (j))
#define XB_XGEN(j)  (2304 + 64 * (j))
#define XB_TOP      3328
#define XB_TOPGEN   3392
#define XCD_BAR_WORDS 3456
#define XB_SPIN_CAP (1u << 20)
__device__ __forceinline__ unsigned xb_ld(unsigned* p)              { return __hip_atomic_load(p, __ATOMIC_RELAXED, __HIP_MEMORY_SCOPE_AGENT); }
__device__ __forceinline__ unsigned xb_add(unsigned* p, unsigned v) { return __hip_atomic_fetch_add(p, v, __ATOMIC_RELAXED, __HIP_MEMORY_SCOPE_AGENT); }
__device__ __forceinline__ unsigned xb_xcc_id() { return (unsigned)__builtin_amdgcn_s_getreg((3 << 11) | 20) & 0xFu; }
#define XB_SPIN(cond, bar) do { unsigned _sp = 0; while (cond) { __builtin_amdgcn_s_sleep(1); \
    if ((++_sp & 255u) == 0u) { if (xb_ld(&(bar)[XB_TMO])) break; if (_sp > XB_SPIN_CAP) { atomicAdd(&(bar)[XB_TMO], 1u); break; } } } } while (0)
struct XcdBarrier { unsigned* bar; unsigned x; volatile LAS unsigned* st; };
__device__ __forceinline__ XcdBarrier xcd_barrier_post(unsigned* bar, volatile LAS unsigned* st) {
    XcdBarrier b; b.bar = bar; b.x = xb_xcc_id(); b.st = st;
    if (threadIdx.x == 0) (void)xb_add(&bar[XB_XCNT(b.x)], 1u);
    return b;
}
__device__ __forceinline__ void xcd_barrier_complete(unsigned* bar, unsigned x, unsigned& nloc, unsigned& nx) {
    const unsigned G = gridDim.x * gridDim.y * gridDim.z;
    unsigned sum, cnt, mine, sp = 0u;
    for (;;) {
        sum = 0u; cnt = 0u; mine = 0u;
#pragma unroll
        for (unsigned j = 0; j < 16; ++j) { const unsigned c = xb_ld(&bar[XB_XCNT(j)]); sum += c; cnt += (c > 0u) ? 1u : 0u; mine = (j == x) ? c : mine; }
        if (sum == G) break;
        __builtin_amdgcn_s_sleep(1);
        if ((++sp & 255u) == 0u) { if (xb_ld(&bar[XB_TMO])) break; if (sp > XB_SPIN_CAP) { atomicAdd(&bar[XB_TMO], 1u); break; } }
    }
    nloc = mine > 0u ? mine : 1u; nx = cnt > 0u ? cnt : 1u;
}
__device__ __forceinline__ void xcd_barrier(const XcdBarrier& b) {
    asm volatile("s_waitcnt vmcnt(0)" ::: "memory");
    __syncthreads();
    if (threadIdx.x == 0) {
        unsigned* bar = b.bar;
        __builtin_amdgcn_s_waitcnt(0);
        unsigned nloc = b.st[0], nx = b.st[1];
        if (nloc == 0u) { xcd_barrier_complete(bar, b.x, nloc, nx); b.st[0] = nloc; b.st[1] = nx; }
        const unsigned old = xb_add(&bar[XB_XSUB(b.x)], 1u);
        const unsigned gen = old / nloc;
        if (old + 1u == (gen + 1u) * nloc) {
            __builtin_amdgcn_fence(__ATOMIC_RELEASE, "agent");
            asm volatile("s_waitcnt vmcnt(0)" ::: "memory");
            const unsigned og = xb_add(&bar[XB_TOP], 1u);
            const unsigned tg = og / nx;
            if (og + 1u == (tg + 1u) * nx) xb_add(&bar[XB_TOPGEN], 1u);
            else XB_SPIN(xb_ld(&bar[XB_TOPGEN]) == tg, bar);
            __builtin_amdgcn_fence(__ATOMIC_ACQUIRE, "agent");
            xb_add(&bar[XB_XGEN(b.x)], 1u);
            asm volatile("s_waitcnt vmcnt(0)" ::: "memory");
        } else {
            XB_SPIN(xb_ld(&bar[XB_XGEN(b.x)]) == gen, bar);
            __builtin_amdgcn_fence(__ATOMIC_ACQUIRE, "agent");
            asm volatile("s_waitcnt vmcnt(0)" ::: "memory");
        }
    }
    __syncthreads();
}

template <int MODE> __device__ __forceinline__ int wmap(int n) {
    if (MODE == 1) { if (n < 6144) { const int pn = n >> 8, x = n & 255, hh = x >> 7, dd = x & 127, bj = dd >> 6, dl = dd & 63; return (pn << 8) + (bj << 7) + (hh << 6) + dl; } return n; }
    if (MODE == 2) { const int up = n >= DFF ? 1 : 0; const int j = up ? n - DFF : n; return ((j >> 7) << 8) + (up << 7) + (j & 127); }
    return n;
}
template <int MODE> __device__ __forceinline__ void transpose_load(const float* W, int N, int item, int lane, float (&v)[32]) {
    const int nblk = N / 32, kb = item / nblk, nb = item % nblk, k0 = 64 * kb, n0 = 32 * nb;
    const float* p = W + (size_t)(k0 + (lane >> 5)) * N + n0 + (lane & 31);
#pragma unroll
    for (int i = 0; i < 32; ++i) v[i] = p[(size_t)(2 * i) * N];
}
template <int MODE> __device__ __forceinline__ void transpose_store(const float (&v)[32], int K, int N, bf16_t* WT, LAS float* scr, int item, int lane, const float* ksc) {
    const int nblk = N / 32, kb = item / nblk, nb = item % nblk, k0 = 64 * kb, n0 = 32 * nb;
#pragma unroll
    for (int i = 0; i < 32; ++i) { const int kk = 2 * i + (lane >> 5); scr[kk * 33 + (lane & 31)] = v[i]; }
    asm volatile("s_waitcnt lgkmcnt(0)" ::: "memory");
    const int c = lane & 7; const int d0 = wmap<MODE>(n0);
    f32x4 ka = (f32x4){1.f, 1.f, 1.f, 1.f}, kb_ = ka;
    if (MODE == 2) { ka = *(const f32x4*)(ksc + k0 + 8 * c); kb_ = *(const f32x4*)(ksc + k0 + 8 * c + 4); }
#pragma unroll
    for (int j = 0; j < 4; ++j) { const int n = (lane >> 3) + 8 * j; const LAS float* s = scr + (8 * c) * 33 + n;
        u32x4 o; o.x = cvtpk(s[0 * 33] * ka[0], s[1 * 33] * ka[1]); o.y = cvtpk(s[2 * 33] * ka[2], s[3 * 33] * ka[3]); o.z = cvtpk(s[4 * 33] * kb_[0], s[5 * 33] * kb_[1]); o.w = cvtpk(s[6 * 33] * kb_[2], s[7 * 33] * kb_[3]);
        if (MODE == 1) *(u32x4*)(WT + (size_t)(d0 + n) * K + k0 + 8 * c) = o;
        else __builtin_nontemporal_store(o, (u32x4*)(WT + (size_t)(d0 + n) * K + k0 + 8 * c)); }
    asm volatile("s_waitcnt lgkmcnt(0)" ::: "memory");
}
template <int MODE> __device__ __forceinline__ void transpose_all(const float* W, int K, int N, bf16_t* WT, LAS unsigned char* lds, int gw, int ngw, int wave, int lane, const float* ksc = nullptr) {
    LAS float* scr = (LAS float*)(lds + wave * 16384);
    const int nitems = (K / 64) * (N / 32);
    float cur[32], nxt[32];
    if (gw < nitems) transpose_load<MODE>(W, N, gw, lane, cur);
    for (int it = gw; it < nitems; it += ngw) {
        const bool more = it + ngw < nitems;
        if (more) transpose_load<MODE>(W, N, it + ngw, lane, nxt);
        transpose_store<MODE>(cur, K, N, WT, scr, it, lane, ksc);
        if (more) {
#pragma unroll
            for (int i = 0; i < 32; ++i) cur[i] = nxt[i];
        }
    }
}

__device__ __forceinline__ void attn_unit(LAS unsigned char* lds, int a, const bf16_t* Qm, const bf16_t* Km, const bf16_t* Vm, bf16_t* Om, float* lse) {
    const int tid = threadIdx.x, lane = tid & 63, wid = __builtin_amdgcn_readfirstlane(tid >> 6), r = lane & 31, h = lane >> 5;
    const int g = a >> 10; int rem = a & 1023; const int b = rem >> 9; rem &= 511; const int hd = rem >> 6, blk = rem & 63;
    const int dsh = 2 * g, nsh = 6 - dsh;
    const int res = blk >> nsh, ub = blk & ((1 << nsh) - 1), u0 = ub * 128;
    const int col = (g * 8 + hd) * 128;
    const size_t rowbase = (size_t)b * SEQ + res;
    LAS unsigned char* Ks = lds; LAS unsigned char* Vs = lds + 65536;
    const int kk_lo = (u0 == 0) ? 128 : 0;
    {
        u32x4 kvr[8], vvr[8];
#pragma unroll
        for (int i = 0; i < 8; ++i) {
            const int idx = tid + 512 * i, kk = idx >> 4, c = idx & 15;
            const int uu = u0 - 128 + (kk < kk_lo ? kk_lo : kk);
            const size_t grow = rowbase + ((size_t)uu << dsh);
            kvr[i] = *(const u32x4*)(Km + grow * 3072 + col + c * 8);
            vvr[i] = *(const u32x4*)(Vm + grow * 3072 + col + c * 8);
        }
#pragma unroll
        for (int i = 0; i < 8; ++i) {
            const int idx = tid + 512 * i, kk = idx >> 4, c = idx & 15;
            *(LAS u32x4*)(Ks + kk * 256 + ((c ^ (kk & 15)) << 4)) = kvr[i];
            *(LAS u32x4*)(Vs + kk * 256 + (((c >> 1) ^ (kk & 7)) << 5) + ((c & 1) << 4)) = vvr[i];
        }
    }
    const int qj = lane & 15, qd = lane >> 4;
    const size_t qrow = rowbase + ((size_t)(u0 + 16 * wid + qj) << dsh);
    bf16x8 qf[4];
#pragma unroll
    for (int ks = 0; ks < 4; ++ks) qf[ks] = __builtin_bit_cast(bf16x8, *(const u32x4*)(Qm + qrow * 3072 + col + 32 * ks + 8 * qd));
    __syncthreads();
    f32x4 sc[9];
    const int tskip = (u0 == 0) ? (8 - wid) : 0;
#pragma unroll
    for (int t = 0; t < 9; ++t) {
        f32x4 acc = (f32x4){0.f, 0.f, 0.f, 0.f};
        if (t >= tskip) {
            const int kr = 16 * wid + 16 * t + qj;
#pragma unroll
            for (int ks = 0; ks < 4; ++ks) { const bf16x8 kf = *(const LAS bf16x8*)(Ks + kr * 256 + (((4 * ks + qd) ^ (kr & 15)) << 4)); acc = __builtin_amdgcn_mfma_f32_16x16x32_bf16(kf, qf[ks], acc, 0, 0, 0); }
        } else acc = (f32x4){-INFINITY, -INFINITY, -INFINITY, -INFINITY};
        sc[t] = acc;
    }
#pragma unroll
    for (int e = 0; e < 4; ++e) { if (4 * qd + e < qj) sc[0][e] = -INFINITY; if (4 * qd + e > qj) sc[8][e] = -INFINITY; }
    float mx = sc[8][0];
#pragma unroll
    for (int t = 0; t < 9; ++t)
#pragma unroll
        for (int e = 0; e < 4; ++e) mx = fmaxf(mx, sc[t][e]);
    mx = fmaxf(mx, __shfl_xor(mx, 16)); mx = fmaxf(mx, __shfl_xor(mx, 32));
    float l = 0.f;
#pragma unroll
    for (int t = 0; t < 9; ++t)
#pragma unroll
        for (int e = 0; e < 4; ++e) { sc[t][e] = __builtin_amdgcn_exp2f(sc[t][e] - mx); l += sc[t][e]; }
    l += __shfl_xor(l, 16); l += __shfl_xor(l, 32);
    f32x4 o[8];
#pragma unroll
    for (int db = 0; db < 8; ++db) o[db] = (f32x4){0.f, 0.f, 0.f, 0.f};
    const int q4 = (lane & 15) >> 2, p4 = lane & 3;
#pragma unroll
    for (int st = 0; st < 5; ++st) {
        if (2 * st + 1 < tskip) continue;
        u32x4 pw; pw.x = cvtpk(sc[2 * st][0], sc[2 * st][1]); pw.y = cvtpk(sc[2 * st][2], sc[2 * st][3]);
        if (st < 4) { pw.z = cvtpk(sc[2 * st + 1][0], sc[2 * st + 1][1]); pw.w = cvtpk(sc[2 * st + 1][2], sc[2 * st + 1][3]); } else { pw.z = 0u; pw.w = 0u; }
        const bf16x8 pb = __builtin_bit_cast(bf16x8, pw);
        const int key0 = 16 * wid + 32 * st + 4 * qd + q4;
        const int key1 = (st < 4) ? key0 + 16 : key0;
#pragma unroll
        for (int db = 0; db < 8; ++db) {
            const int so = ((db ^ (key0 & 7)) << 5) + 8 * p4;
            const s16x4 lo = trd(Vs + key0 * 256 + so), hi = trd(Vs + key1 * 256 + so);
            const bf16x8 af = __builtin_shufflevector(lo, hi, 0, 1, 2, 3, 4, 5, 6, 7);
            o[db] = __builtin_amdgcn_mfma_f32_16x16x32_bf16(af, pb, o[db], 0, 0, 0);
        }
    }
    const float inv = 1.f / l;
    __syncthreads();
    LAS unsigned char* stg = lds + wid * 4608;
#pragma unroll
    for (int db = 0; db < 8; ++db) {
        u32x2 w; w.x = cvtpk(o[db][0] * inv, o[db][1] * inv); w.y = cvtpk(o[db][2] * inv, o[db][3] * inv);
        *(LAS u32x2*)(stg + qj * 272 + (16 * db + 4 * qd) * 2) = w;
    }
    asm volatile("s_waitcnt lgkmcnt(0)" ::: "memory");
#pragma unroll
    for (int ps = 0; ps < 4; ++ps) {
        const int row = ps * 4 + (lane >> 4), ch = lane & 15;
        const u32x4 v = *(const LAS u32x4*)(stg + row * 272 + ch * 16);
        const size_t grow = rowbase + ((size_t)(u0 + 16 * wid + row) << dsh);
        *(u32x4*)(Om + grow * 3072 + col + ch * 8) = v;
    }
    if (qd == 0) lse[((size_t)g * MTOK + qrow) * 8 + hd] = mx + __builtin_amdgcn_logf(l);
    __syncthreads();
}

constexpr int HL_GB = 0, HL_PP = 33024, HL_RED = 35072, HL_QT = 36864, HL_KT = 53248, HL_KHT = 69632, HL_VT = 86016, HL_STG = 102400;
template <bool PASS_A> __device__ __forceinline__ void hgrn_setup(LAS unsigned char* lds, int b, int hd, int c, const bf16_t* HG, const float* LB) {
    const int tid = threadIdx.x;
    LAS float* GB = (LAS float*)(lds + HL_GB); LAS float* PP = (LAS float*)(lds + HL_PP);
    const size_t row0 = (size_t)b * SEQ + (size_t)c * 64;
#pragma unroll
    for (int i = 0; i < 2; ++i) {
        const int q = tid + 512 * i, t = q >> 4, cc = q & 15;
        const bf16_t* rp = HG + (row0 + t) * 4096 + hd * 128 + cc * 8;
        const u32x4 fw = *(const u32x4*)(rp + 1024), iw = *(const u32x4*)(rp + 2048);
        if (!PASS_A) { const u32x4 qw = *(const u32x4*)(rp); *(LAS u32x4*)(lds + HL_QT + t * 256 + ((cc ^ (t & 15)) << 4)) = qw; }
        *(LAS u32x4*)(lds + HL_KT + t * 256 + ((cc ^ (t & 15)) << 4)) = fw;
        *(LAS u32x4*)(lds + HL_STG + t * 272 + cc * 16) = iw;
    }
    __syncthreads();
    float omr[2][8];
#pragma unroll
    for (int i = 0; i < 2; ++i) {
        const int q = tid + 512 * i, t = q & 63, cc = q >> 6;
        const u32x4 fw = *(const LAS u32x4*)(lds + HL_KT + t * 256 + ((cc ^ (t & 15)) << 4));
        const unsigned fws[4] = {fw.x, fw.y, fw.z, fw.w};
#pragma unroll
        for (int e = 0; e < 8; ++e) {
            const float x = (e & 1) ? bfhi(fws[e >> 1]) : bflo(fws[e >> 1]);
            const float lbv = LB[hd * 128 + cc * 8 + e];
            const float ef = __builtin_amdgcn_exp2f(-1.4426950408889634f * x), sg = __builtin_amdgcn_rcpf(1.f + ef);
            const float f = lbv + (1.f - lbv) * sg;
            omr[i][e] = (1.f - lbv) * ef * sg;
            GB[t * 129 + cc * 8 + e] = __builtin_amdgcn_logf(f);
        }
    }
    __syncthreads();
    {
        const int k = tid & 127, part = tid >> 7; float accv = 0.f;
#pragma unroll
        for (int j = 0; j < 16; ++j) { const int t = 16 * part + j; accv += GB[t * 129 + k]; GB[t * 129 + k] = accv; }
        PP[part * 128 + k] = accv;
        __syncthreads();
        float off = 0.f;
        for (int pp = 0; pp < part; ++pp) off += PP[pp * 128 + k];
        if (part > 0) {
#pragma unroll
            for (int j = 0; j < 16; ++j) { const int t = 16 * part + j; GB[t * 129 + k] += off; }
        }
        if (part == 0) ((LAS float*)(lds + HL_RED))[k] = (PP[k] + PP[128 + k]) + (PP[256 + k] + PP[384 + k]);
    }
    __syncthreads();
#pragma unroll
    for (int i = 0; i < 2; ++i) {
        const int q = tid + 512 * i, t = q & 63, cc = q >> 6;
        const u32x4 qw = *(const LAS u32x4*)(lds + HL_QT + t * 256 + ((cc ^ (t & 15)) << 4)), fw = *(const LAS u32x4*)(lds + HL_KT + t * 256 + ((cc ^ (t & 15)) << 4)),
                    iw = *(const LAS u32x4*)(lds + HL_STG + t * 272 + cc * 16);
        const unsigned qws[4] = {qw.x, qw.y, qw.z, qw.w}, fws[4] = {fw.x, fw.y, fw.z, fw.w}, iws[4] = {iw.x, iw.y, iw.z, iw.w};
        float qt[8], kt[8];
#pragma unroll
        for (int e = 0; e < 8; ++e) {
            const int k = cc * 8 + e;
            const float bb = GB[t * 129 + k];
            const float om = omr[i][e];
            if (PASS_A) {
                const float bl = ((const LAS float*)(lds + HL_RED))[k];
                const float kh = om * __builtin_amdgcn_exp2f(bl - bb);
                const unsigned khb = cvtpk(kh, 0.f) & 0xffffu;
                *(LAS unsigned short*)(lds + HL_KHT + k * 128 + (((t >> 3) ^ (k & 7)) << 4) + (t & 7) * 2) = (unsigned short)khb;
            } else {
                const float qx = (e & 1) ? bfhi(qws[e >> 1]) : bflo(qws[e >> 1]);
                const float eb = __builtin_amdgcn_exp2f(bb), eq1 = 1.f + __builtin_amdgcn_exp2f(-1.4426950408889634f * qx);
                const float rr = __builtin_amdgcn_rcpf(eb * eq1);
                qt[e] = qx * eb * (rr * eb);
                kt[e] = om * (rr * eq1);
            }
            const unsigned iv = (e & 1) ? (iws[e >> 1] >> 16) : (iws[e >> 1] & 0xffffu);
            *(LAS unsigned short*)(lds + HL_VT + k * 128 + (((t >> 3) ^ (k & 7)) << 4) + (t & 7) * 2) = (unsigned short)iv;
        }
        if (!PASS_A) {
            u32x4 w; w.x = cvtpk(qt[0], qt[1]); w.y = cvtpk(qt[2], qt[3]); w.z = cvtpk(qt[4], qt[5]); w.w = cvtpk(qt[6], qt[7]);
            *(LAS u32x4*)(lds + HL_QT + t * 256 + ((cc ^ (t & 15)) << 4)) = w;
            w.x = cvtpk(kt[0], kt[1]); w.y = cvtpk(kt[2], kt[3]); w.z = cvtpk(kt[4], kt[5]); w.w = cvtpk(kt[6], kt[7]);
            *(LAS u32x4*)(lds + HL_KT + t * 256 + ((cc ^ (t & 15)) << 4)) = w;
        }
    }
    __syncthreads();
}
__device__ __forceinline__ void hgrn_pass_a(LAS unsigned char* lds, int unit, const bf16_t* HG, const float* LB, bf16_t* S, float* DEC) {
    const int tid = threadIdx.x, lane = tid & 63, wid = __builtin_amdgcn_readfirstlane(tid >> 6), r = lane & 31, h = lane >> 5;
    const int b = unit >> 10, hd = (unit >> 7) & 7, c = unit & 127;
    hgrn_setup<true>(lds, b, hd, c, HG, LB);
    const int vb = wid >> 1;
    bf16_t* Sg = S + (size_t)unit * 16384;
#pragma unroll
    for (int kbi = 0; kbi < 2; ++kbi) {
        const int kb = 2 * (wid & 1) + kbi;
        f32x16 acc;
#pragma unroll
        for (int i = 0; i < 16; ++i) acc[i] = 0.f;
        const int v = 32 * vb + r, k = 32 * kb + r;
#pragma unroll
        for (int ts = 0; ts < 4; ++ts) {
            const int ch = 2 * ts + h;
            const bf16x8 af = *(const LAS bf16x8*)(lds + HL_VT + v * 128 + ((ch ^ (v & 7)) << 4));
            const bf16x8 bf = *(const LAS bf16x8*)(lds + HL_KHT + k * 128 + ((ch ^ (k & 7)) << 4));
            acc = MFMA32(af, bf, acc);
        }
#pragma unroll
        for (int i = 0; i < 16; ++i) *(LAS unsigned short*)(lds + HL_GB + (32 * vb + crow(i, h)) * 256 + k * 2) = (unsigned short)(cvtpk(acc[i], 0.f) & 0xffffu);
    }
    __syncthreads();
#pragma unroll
    for (int i = 0; i < 4; ++i) { const int q = tid + 512 * i; *(u32x4*)(Sg + q * 8) = *(const LAS u32x4*)(lds + HL_GB + q * 16); }
    if (tid < 128) DEC[(size_t)unit * 128 + tid] = __builtin_amdgcn_exp2f(((const LAS float*)(lds + HL_RED))[tid]);
    __syncthreads();
}
__device__ __forceinline__ void hgrn_pass_c(LAS unsigned char* lds, int unit, bf16_t* HG, const float* LB, const bf16_t* S, const float* hgain, const bf16_t* Og, const float* lse) {
    const int tid = threadIdx.x, lane = tid & 63, wid = __builtin_amdgcn_readfirstlane(tid >> 6), r = lane & 31, h = lane >> 5;
    const int b = unit >> 10, hd = (unit >> 7) & 7, c = unit & 127;
    hgrn_setup<false>(lds, b, hd, c, HG, LB);
    const int vb = wid >> 1, tb = wid & 1;
    const bf16_t* Sg = S + (size_t)unit * 16384;
    f32x16 o;
#pragma unroll
    for (int i = 0; i < 16; ++i) o[i] = 0.f;
    const int trow = 32 * tb + r, vrow = 32 * vb + r;
    bf16x8 qf[8];
#pragma unroll
    for (int ks = 0; ks < 8; ++ks) qf[ks] = *(const LAS bf16x8*)(lds + HL_QT + trow * 256 + (((2 * ks + h) ^ (trow & 15)) << 4));
#pragma unroll
    for (int ks = 0; ks < 8; ++ks) { const bf16x8 af = __builtin_bit_cast(bf16x8, *(const u32x4*)(Sg + vrow * 128 + 16 * ks + 8 * h)); o = MFMA32(af, qf[ks], o); }
    for (int sb = 0; sb <= tb; ++sb) {
        f32x16 X;
#pragma unroll
        for (int i = 0; i < 16; ++i) X[i] = 0.f;
        const int srow = 32 * sb + r;
#pragma unroll
        for (int ks = 0; ks < 8; ++ks) { const bf16x8 af = *(const LAS bf16x8*)(lds + HL_KT + srow * 256 + (((2 * ks + h) ^ (srow & 15)) << 4)); X = MFMA32(af, qf[ks], X); }
        if (sb == tb) {
#pragma unroll
            for (int i = 0; i < 16; ++i) if (crow(i, h) > r) X[i] = 0.f;
        }
#pragma unroll
        for (int ss = 0; ss < 2; ++ss) {
            const bf16x8 pb = pack8(X, 8 * ss);
            const int c0 = 4 * sb + 2 * ss;
            const u32x2 lo = *(const LAS u32x2*)(lds + HL_VT + vrow * 128 + ((c0 ^ (vrow & 7)) << 4) + 8 * h);
            const u32x2 hi = *(const LAS u32x2*)(lds + HL_VT + vrow * 128 + (((c0 + 1) ^ (vrow & 7)) << 4) + 8 * h);
            u32x4 aw; aw.x = lo.x; aw.y = lo.y; aw.z = hi.x; aw.w = hi.y;
            o = MFMA32(__builtin_bit_cast(bf16x8, aw), pb, o);
        }
    }
    float ssq = 0.f;
#pragma unroll
    for (int i = 0; i < 16; ++i) ssq += o[i] * o[i];
    ssq += __shfl_xor(ssq, 32);
    LAS float* RED = (LAS float*)(lds + HL_RED);
    if (h == 0) RED[vb * 64 + trow] = ssq;
    __syncthreads();
    const float tot = (RED[trow] + RED[64 + trow]) + (RED[128 + trow] + RED[192 + trow]);
    const float rstd = rsqrtf(tot * (1.f / 128.f) + EPS);
#pragma unroll
    for (int gq = 0; gq < 4; ++gq) {
        u32x2 w; w.x = cvtpk(o[4 * gq] * rstd, o[4 * gq + 1] * rstd); w.y = cvtpk(o[4 * gq + 2] * rstd, o[4 * gq + 3] * rstd);
        *(LAS u32x2*)(lds + HL_STG + trow * 272 + (32 * vb + 8 * gq + 4 * h) * 2) = w;
    }
    __syncthreads();
    const size_t row0 = (size_t)b * SEQ + (size_t)c * 64;
#pragma unroll
    for (int i = 0; i < 2; ++i) {
        const int q = tid + 512 * i, t = q >> 4, cc = q & 15;
        const size_t row = row0 + t;
        bf16_t* rp = HG + row * 4096 + hd * 128 + cc * 8;
        const u32x4 ov = *(const LAS u32x4*)(lds + HL_STG + t * 272 + cc * 16);
        const u32x4 gw = *(const u32x4*)(rp + 3072);
        const f32x4 ga = *(const f32x4*)(hgain + hd * 128 + cc * 8), gb = *(const f32x4*)(hgain + hd * 128 + cc * 8 + 4);
        const float gn[8] = {ga[0], ga[1], ga[2], ga[3], gb[0], gb[1], gb[2], gb[3]};
        const unsigned ovs[4] = {ov.x, ov.y, ov.z, ov.w}, gws[4] = {gw.x, gw.y, gw.z, gw.w};
        float ro[8];
#pragma unroll
        for (int e = 0; e < 4; ++e) { ro[2 * e] = bflo(ovs[e]) * gn[2 * e] * siluf_(bflo(gws[e])); ro[2 * e + 1] = bfhi(ovs[e]) * gn[2 * e + 1] * siluf_(bfhi(gws[e])); }
        const float l0 = lse[((size_t)0 * MTOK + row) * 8 + hd], l1 = lse[((size_t)1 * MTOK + row) * 8 + hd], l2 = lse[((size_t)2 * MTOK + row) * 8 + hd];
        const float mx = fmaxf(l0, fmaxf(l1, l2));
        float w0 = __builtin_amdgcn_exp2f(l0 - mx), w1 = __builtin_amdgcn_exp2f(l1 - mx), w2 = __builtin_amdgcn_exp2f(l2 - mx);
        const float wi = 1.f / (w0 + w1 + w2); w0 *= wi; w1 *= wi; w2 *= wi;
        const bf16_t* op = Og + row * 3072 + hd * 128 + cc * 8;
        const u32x4 a0 = *(const u32x4*)(op), a1 = *(const u32x4*)(op + 1024), a2 = *(const u32x4*)(op + 2048);
        const unsigned a0s[4] = {a0.x, a0.y, a0.z, a0.w}, a1s[4] = {a1.x, a1.y, a1.z, a1.w}, a2s[4] = {a2.x, a2.y, a2.z, a2.w};
        u32x4 wr_, wa_;
        unsigned wrs[4], was[4];
#pragma unroll
        for (int e = 0; e < 4; ++e) {
            wrs[e] = cvtpk(ro[2 * e], ro[2 * e + 1]);
            was[e] = cvtpk(w0 * bflo(a0s[e]) + w1 * bflo(a1s[e]) + w2 * bflo(a2s[e]), w0 * bfhi(a0s[e]) + w1 * bfhi(a1s[e]) + w2 * bfhi(a2s[e]));
        }
        wr_.x = wrs[0]; wr_.y = wrs[1]; wr_.z = wrs[2]; wr_.w = wrs[3];
        wa_.x = was[0]; wa_.y = was[1]; wa_.z = was[2]; wa_.w = was[3];
        *(u32x4*)(rp) = wr_;
        *(u32x4*)(rp + 1024) = wa_;
    }
    __syncthreads();
}

__global__ void __launch_bounds__(NTHR, 2) fwd_megakernel(Args args) {
    extern __shared__ __attribute__((aligned(16))) unsigned char lds_raw[];
    cg::grid_group grid = cg::this_grid();
    LAS unsigned char* lds = (LAS unsigned char*)lds_raw;
    const int tid = threadIdx.x, lane = tid & 63, wave = __builtin_amdgcn_readfirstlane(tid >> 6);
    const int G = gridDim.x, bx = blockIdx.x;
    const int gw = bx * NWAVES + wave, ngw = G * NWAVES;
    unsigned char* ws = args.ws;
    if (args.out == nullptr) grid.sync();
    volatile LAS unsigned* bst = (volatile LAS unsigned*)(lds + 131072 + 64);
    if (tid < 2) bst[tid] = 0u;
    __syncthreads();
    const XcdBarrier gbar = xcd_barrier_post((unsigned*)(ws + WS_BAR), bst);
    const float* x = args.in[0]; const float* w_in = args.in[1]; const float* w_pa = args.in[2]; const float* w_pr = args.in[3]; const float* w_o = args.in[4];
    const float* lbraw = args.in[5]; const float* hgain = args.in[6]; const float* g_pre = args.in[7]; const float* g_post = args.in[8];
    const float* w_gu = args.in[9]; const float* w_dn = args.in[10]; const float* g_fpre = args.in[11]; const float* g_fpost = args.in[12];
    float* out = args.out;
    float* LB = (float*)(ws + WS_LB); float* LSE = (float*)(ws + WS_LSE); float* DEC = (float*)(ws + WS_DEC); float* ROPE = (float*)(ws + WS_ROPE);
    bf16_t* WIN_T = (bf16_t*)(ws + WS_WIN); bf16_t* XN = (bf16_t*)(ws + WS_XN); bf16_t* Qb = (bf16_t*)(ws + WS_Q); bf16_t* Kb = (bf16_t*)(ws + WS_K); bf16_t* Vb = (bf16_t*)(ws + WS_V);
    bf16_t* Sb = (bf16_t*)(ws + WS_S); bf16_t* HG = (bf16_t*)out;
    bf16_t* WPA_T = (bf16_t*)(ws + WS_WPA); bf16_t* WPR_T = (bf16_t*)(ws + WS_WPR); bf16_t* WO_T = (bf16_t*)(ws + WS_WO); bf16_t* WDN_T = (bf16_t*)(ws + WS_WDN);
    bf16_t* WGU_T = (bf16_t*)(ws + WS_WGU); bf16_t* Gt = (bf16_t*)(ws + WS_G); bf16_t* Yb = (bf16_t*)(ws + WS_Y); bf16_t* Z = (bf16_t*)(ws + WS_Z);
    bf16_t* A2 = (bf16_t*)(ws + WS_A2); bf16_t* FFH = (bf16_t*)(ws + WS_FFH); bf16_t* Z2 = (bf16_t*)(ws + WS_Z2);
    float* RSTD0 = (float*)(ws + WS_RSTD0); float* R2 = (float*)(ws + WS_R2);
    bf16_t* H1B = (bf16_t*)(ws + WS_Y);

    transpose_all<1>(w_in, DM, NIN, WIN_T, lds, gw, ngw, wave, lane);
    {
    f32x4 gpre[8];
#pragma unroll
    for (int j = 0; j < 8; ++j) gpre[j] = ((const f32x4*)g_pre)[128 * (j >> 1) + 2 * lane + (j & 1)];
    for (int row = gw; row < MTOK; row += ngw) {
        const f32x4* xr = (const f32x4*)(x + (size_t)row * DM) + 2 * lane;
        f32x4 v[8]; float s = 0.f;
#pragma unroll
        for (int j = 0; j < 8; ++j) { v[j] = xr[128 * (j >> 1) + (j & 1)]; s += (v[j][0] * v[j][0] + v[j][1] * v[j][1]) + (v[j][2] * v[j][2] + v[j][3] * v[j][3]); }
        const float rstd = rsqrtf(wave_sum(s) * (1.f / DM) + EPS);
        if (lane == 0) RSTD0[row] = rstd;
        u32x4* o16 = (u32x4*)(XN + (size_t)row * DM) + lane;
#pragma unroll
        for (int jj = 0; jj < 4; ++jj) { const f32x4 g0 = gpre[2 * jj], g1 = gpre[2 * jj + 1], p = v[2 * jj], q = v[2 * jj + 1]; u32x4 w;
            w.x = cvtpk(p[0] * rstd * g0[0], p[1] * rstd * g0[1]); w.y = cvtpk(p[2] * rstd * g0[2], p[3] * rstd * g0[3]);
            w.z = cvtpk(q[0] * rstd * g1[0], q[1] * rstd * g1[1]); w.w = cvtpk(q[2] * rstd * g1[2], q[3] * rstd * g1[3]); o16[64 * jj] = w; }
    }
    }
    if (bx == 0 && tid < 64) ROPE[tid] = args.inv_freq[tid];
    if (bx == 0) for (int j = tid; j < 1024; j += NTHR) LB[j] = 1.f / (1.f + __expf(lbraw[1024 + j] - lbraw[j]));
    xcd_barrier(gbar);

    {
        pg8::Gemm g{XN, WIN_T, MTOK, 13312, DM, DM, DM}; pg8::StaticOrder S; S.init(MTOK, 13312, G, bx);
        pg8::EpiProj E{Qb, Kb, Vb, HG, ROPE};
        pg8::gemm_phase<pg8::EpiProj, pg8::StaticOrder, true, true>(lds, g, S, E);
    }
    xcd_barrier(gbar);

    {
        const int vcu = ((G & 7) == 0) ? (bx & 7) * (G >> 3) + (bx >> 3) : bx;
        for (int a = vcu; a < 3072; a += G) attn_unit(lds, a, Qb, Kb, Vb, Qb, LSE);
    }
    for (int u = bx; u < 2048; u += G) hgrn_pass_a(lds, u, HG, LB, Sb, DEC);
    xcd_barrier(gbar);

    for (int idx = bx * NTHR + tid; idx < 16 * 8192; idx += G * NTHR) {
        const int bh = idx >> 13, e2 = idx & 8191;
        unsigned* sp = (unsigned*)(Sb + (size_t)bh * 128 * 16384) + e2;
        const float* dp = DEC + (size_t)bh * 128 * 128 + ((2 * e2) & 127);
        float c0 = 0.f, c1 = 0.f;
        for (int cb = 0; cb < 128; cb += 16) {
            unsigned wv[16]; float d0v[16], d1v[16];
#pragma unroll
            for (int c = 0; c < 16; ++c) { wv[c] = sp[(size_t)(cb + c) * 8192]; d0v[c] = dp[(cb + c) * 128]; d1v[c] = dp[(cb + c) * 128 + 1]; }
#pragma unroll
            for (int c = 0; c < 16; ++c) { const unsigned w = wv[c]; wv[c] = cvtpk(c0, c1); c0 = d0v[c] * c0 + bflo(w); c1 = d1v[c] * c1 + bfhi(w); }
#pragma unroll
            for (int c = 0; c < 16; ++c) sp[(size_t)(cb + c) * 8192] = wv[c];
        }
    }
    transpose_all<0>(w_pa, 1024, DM, WPA_T, lds, gw, ngw, wave, lane);
    transpose_all<0>(w_pr, 1024, DM, WPR_T, lds, gw, ngw, wave, lane);
    transpose_all<0>(w_o, DM, DM, WO_T, lds, gw, ngw, wave, lane);
    transpose_all<0>(w_dn, DFF, DM, WDN_T, lds, gw, ngw, wave, lane);
    transpose_all<2>(w_gu, DM, 2 * DFF, WGU_T, lds, gw, ngw, wave, lane, g_fpre);
    __syncthreads();
    {
        pg8::Gemm g{XN, (const bf16_t*)(ws + WS_WING), MTOK, 4096, DM, DM, DM}; pg8::StaticOrder S; S.init(MTOK, 4096, G, bx);
        pg8::EpiPlain E{Gt, 4096};
        pg8::gemm_phase<pg8::EpiPlain, pg8::StaticOrder, true, true>(lds, g, S, E);
    }
    xcd_barrier(gbar);

    for (int u = bx; u < 2048; u += G) hgrn_pass_c(lds, u, HG, LB, Sb, hgain, Qb, LSE);
    xcd_barrier(gbar);

    {
        pg8::PairOrder S; S.init(MTOK, DM, G, bx); S.A20 = HG + 1024; S.A21 = HG; S.B20 = WPA_T; S.B21 = WPR_T;
        pg8::Gemm g{HG, WPA_T, MTOK, DM, 1024, 4096, 1024};
        pg8::EpiGate2 E{Yb, Gt};
        pg8::gemm_phase<pg8::EpiGate2, pg8::PairOrder, true, true>(lds, g, S, E);
    }
    xcd_barrier(gbar);

    {
        pg8::Gemm g{Yb, WO_T, MTOK, DM, DM, DM, DM}; pg8::StaticOrder S; S.init(MTOK, DM, G, bx);
        pg8::EpiPlain E{Z, DM};
        pg8::gemm_phase<pg8::EpiPlain, pg8::StaticOrder, true, true>(lds, g, S, E);
    }
    xcd_barrier(gbar);

    {
    int lane = threadIdx.x & 63; asm volatile("" : "+v"(lane));
    int gw = bx * NWAVES + __builtin_amdgcn_readfirstlane(threadIdx.x >> 6); asm volatile("" : "+s"(gw));
    f32x4 gpo[8], igp[8];
#pragma unroll
    for (int j = 0; j < 8; ++j) { const int gi = 128 * (j >> 1) + 2 * lane + (j & 1); gpo[j] = ((const f32x4*)g_post)[gi];
        const f32x4 gq = ((const f32x4*)g_pre)[gi]; igp[j] = (f32x4){1.f / gq[0], 1.f / gq[1], 1.f / gq[2], 1.f / gq[3]}; }
    for (int row = gw; row < MTOK; row += ngw) {
        const u32x4* zr = (const u32x4*)(Z + (size_t)row * DM) + lane; const u32x4* xr = (const u32x4*)(XN + (size_t)row * DM) + lane;
        const float ir0 = 1.f / RSTD0[row];
        u32x4 zq[4], xq[4];
#pragma unroll
        for (int jj = 0; jj < 4; ++jj) { zq[jj] = zr[64 * jj]; xq[jj] = xr[64 * jj]; }
        f32x4 v[8], xv8[8]; float s = 0.f;
#pragma unroll
        for (int j = 0; j < 8; ++j) { const unsigned z0 = (j & 1) ? zq[j >> 1].z : zq[j >> 1].x, z1 = (j & 1) ? zq[j >> 1].w : zq[j >> 1].y;
            const unsigned x0 = (j & 1) ? xq[j >> 1].z : xq[j >> 1].x, x1 = (j & 1) ? xq[j >> 1].w : xq[j >> 1].y;
            v[j] = (f32x4){bflo(z0), bfhi(z0), bflo(z1), bfhi(z1)};
            xv8[j] = (f32x4){bflo(x0) * ir0 * igp[j][0], bfhi(x0) * ir0 * igp[j][1], bflo(x1) * ir0 * igp[j][2], bfhi(x1) * ir0 * igp[j][3]};
            s += (v[j][0] * v[j][0] + v[j][1] * v[j][1]) + (v[j][2] * v[j][2] + v[j][3] * v[j][3]); }
        const float r1 = rsqrtf(wave_sum(s) * (1.f / DM) + EPS);
        float s2 = 0.f;
#pragma unroll
        for (int j = 0; j < 8; ++j) { const f32x4 gg = gpo[j]; const f32x4 xv = xv8[j]; f32x4 hv;
            hv[0] = xv[0] + v[j][0] * r1 * gg[0]; hv[1] = xv[1] + v[j][1] * r1 * gg[1]; hv[2] = xv[2] + v[j][2] * r1 * gg[2]; hv[3] = xv[3] + v[j][3] * r1 * gg[3];
            v[j] = hv; s2 += (hv[0] * hv[0] + hv[1] * hv[1]) + (hv[2] * hv[2] + hv[3] * hv[3]); }
        const float r2 = rsqrtf(wave_sum(s2) * (1.f / DM) + EPS);
        if (lane == 0) R2[row] = r2;
        u32x4* h16 = (u32x4*)(H1B + (size_t)row * DM) + lane;
#pragma unroll
        for (int jj = 0; jj < 4; ++jj) { const f32x4 p = v[2 * jj], q = v[2 * jj + 1]; u32x4 hw;
            hw.x = cvtpk(p[0], p[1]); hw.y = cvtpk(p[2], p[3]); hw.z = cvtpk(q[0], q[1]); hw.w = cvtpk(q[2], q[3]); h16[64 * jj] = hw; }
    }
    }
    xcd_barrier(gbar);

    {
        pg8::Gemm g{H1B, WGU_T, MTOK, 2 * DFF, DM, DM, DM}; pg8::StaticOrder S; S.init(MTOK, 2 * DFF, G, bx);
        pg8::EpiSwiGLU E{FFH, DFF, R2};
        pg8::gemm_phase<pg8::EpiSwiGLU, pg8::StaticOrder, true, true>(lds, g, S, E);
    }
    xcd_barrier(gbar);

    {
        pg8::Gemm g{FFH, WDN_T, MTOK, DM, DFF, DFF, DFF}; pg8::StaticOrder S; S.init(MTOK, DM, G, bx);
        pg8::EpiPlain E{Z2, DM};
        pg8::gemm_phase<pg8::EpiPlain, pg8::StaticOrder, true, true>(lds, g, S, E);
    }
    xcd_barrier(gbar);

    {
    int lane = threadIdx.x & 63; asm volatile("" : "+v"(lane));
    int gw = bx * NWAVES + __builtin_amdgcn_readfirstlane(threadIdx.x >> 6); asm volatile("" : "+s"(gw));
    f32x4 gfo[8];
#pragma unroll
    for (int j = 0; j < 8; ++j) gfo[j] = ((const f32x4*)g_fpost)[128 * (j >> 1) + 2 * lane + (j & 1)];
    for (int row = gw; row < MTOK; row += ngw) {
        const u32x4* zr = (const u32x4*)(Z2 + (size_t)row * DM) + lane; const u32x4* hr = (const u32x4*)(H1B + (size_t)row * DM) + lane;
        f32x4* orow = (f32x4*)(out + (size_t)row * DM) + 2 * lane;
        u32x4 zq[4], hq[4];
#pragma unroll
        for (int jj = 0; jj < 4; ++jj) { zq[jj] = zr[64 * jj]; hq[jj] = hr[64 * jj]; }
        f32x4 v[8]; float s = 0.f;
#pragma unroll
        for (int j = 0; j < 8; ++j) { const unsigned z0 = (j & 1) ? zq[j >> 1].z : zq[j >> 1].x, z1 = (j & 1) ? zq[j >> 1].w : zq[j >> 1].y;
            v[j] = (f32x4){bflo(z0), bfhi(z0), bflo(z1), bfhi(z1)}; s += (v[j][0] * v[j][0] + v[j][1] * v[j][1]) + (v[j][2] * v[j][2] + v[j][3] * v[j][3]); }
        const float r1 = rsqrtf(wave_sum(s) * (1.f / DM) + EPS);
#pragma unroll
        for (int j = 0; j < 8; ++j) { const f32x4 gg = gfo[j]; const unsigned h0 = (j & 1) ? hq[j >> 1].z : hq[j >> 1].x, h1_ = (j & 1) ? hq[j >> 1].w : hq[j >> 1].y;
            f32x4 hv = (f32x4){bflo(h0), bfhi(h0), bflo(h1_), bfhi(h1_)};
            hv[0] += v[j][0] * r1 * gg[0]; hv[1] += v[j][1] * r1 * gg[1]; hv[2] += v[j][2] * r1 * gg[2]; hv[3] += v[j][3] * r1 * gg[3]; __builtin_nontemporal_store(hv, &orow[128 * (j >> 1) + (j & 1)]); }
    }
    }
}

extern "C" void kernel_launch(void* const* d_in, const int* in_sizes, int n_in, void* d_out, int out_size, void* d_ws, size_t ws_size, hipStream_t stream) {
    static int grid = 0;
    if (grid == 0) {
        if (n_in != 13 || out_size != MTOK * DM || ws_size < WS_END) { fprintf(stderr, "kernel_launch: unexpected shapes (n_in %d out %d ws %zu)\n", n_in, out_size, ws_size); grid = -1; return; }
        int dev = 0, cus = 0, per_cu = 0;
        hipGetDevice(&dev); hipDeviceGetAttribute(&cus, hipDeviceAttributeMultiprocessorCount, dev);
        hipFuncSetAttribute((const void*)fwd_megakernel, hipFuncAttributeMaxDynamicSharedMemorySize, LDS_BYTES);
        hipOccupancyMaxActiveBlocksPerMultiprocessor(&per_cu, (const void*)fwd_megakernel, NTHR, LDS_BYTES);
        if (per_cu < 1) per_cu = 1;
        (void)hipGetLastError();
        grid = cus;
    }
    if (grid < 0) return;
    Args a{};
    for (int i = 0; i < 13; ++i) a.in[i] = (const float*)d_in[i];
    a.out = (float*)d_out; a.ws = (unsigned char*)d_ws;
    for (int i = 0; i < 64; ++i) a.inv_freq[i] = (float)pow(10000.0, -(double)(2 * i) / 128.0);
    (void)hipMemsetAsync((unsigned char*)d_ws + WS_BAR, 0, WS_BAR_BYTES, stream);
    void* kargs[] = {&a};
    hipError_t e = hipLaunchCooperativeKernel((const void*)fwd_megakernel, dim3(grid), dim3(NTHR), kargs, LDS_BYTES, stream);
    if (e != hipSuccess) fprintf(stderr, "cooperative launch failed: %s (grid %d)\n", hipGetErrorString(e), grid);
}
```

```cpp
#include <hip/hip_runtime.h>
#include <hip/hip_cooperative_groups.h>
#include <cstdio>
#include <cstdint>
#include <cmath>
namespace cg = cooperative_groups;

namespace pg8 {
#define PG8_LAS __attribute__((address_space(3)))
typedef unsigned short bf16_t;
typedef short bf16x8 __attribute__((ext_vector_type(8)));
typedef float f32x4 __attribute__((ext_vector_type(4)));
typedef unsigned u32x4 __attribute__((ext_vector_type(4)));
typedef unsigned u32x2 __attribute__((ext_vector_type(2)));
constexpr int BM = 256, BK = 64, HALF = 128, HTB = HALF * BK * 2, STAGE_BYTES = 8 * HTB, NXCD = 8, WGM = 4;

__host__ __device__ __forceinline__ int lds_byte(int r, int c) { const int st = (r >> 4) * 2 + (c >> 5), rr = r & 15, cc = c & 31, ob = rr * 64 + cc * 2; return st * 1024 + (ob ^ (((ob >> 9) & 1) << 5)); }
__host__ __device__ __forceinline__ void stage_rc(int b, int& R, int& C) { const int st = b / 1024, sb = b % 1024, swz = sb ^ (((sb >> 9) & 1) << 5); R = (st >> 1) * 16 + swz / 64; C = (st & 1) * 32 + (swz % 64) / 2; }
__host__ __device__ __forceinline__ int perm32(int rho) { const int n = rho >> 4, i = rho & 15; return 8 * (i >> 2) + 4 * n + (i & 3); }

struct Unit { int pm, pn, half; };
struct Gemm { const bf16_t* A; const bf16_t* Bt; int M, N, K, lda, ldb; };

struct StaticOrder {
    int nM, nN, nwg, G, c;
    __host__ __device__ void init(int M, int N, int G_, int c_) { nM = M / BM; nN = N / BM; nwg = nM * nN; G = G_; c = c_; }
    __host__ __device__ bool next(int i, Unit& u) const {
        const long L = (long)i * G + c; if (L >= nwg) return false;
        int wgid = (int)L; const int xcd_ = wgid % NXCD; { const int q = nwg / NXCD, r = nwg % NXCD, xcd = wgid % NXCD, off = wgid / NXCD; wgid = (xcd < r ? xcd * (q + 1) : r * (q + 1) + (xcd - r) * q) + off; }
        const int nig = WGM * nN, gid = wgid / nig, fm = gid * WGM, gsz = (nM - fm) < WGM ? (nM - fm) : WGM;
        u.pm = fm + ((wgid % nig) % gsz); u.pn = ((wgid % nig) / gsz + xcd_ * (nN / NXCD)) % nN; u.half = 0; return true;
    }
    __device__ __forceinline__ const char* baseA(const Gemm& g, const Unit&) const { return (const char*)g.A; }
    __device__ __forceinline__ const char* baseB(const Gemm& g, const Unit&) const { return (const char*)g.Bt; }
    __device__ __forceinline__ void a_ready(const Unit&) const {}
    __device__ __forceinline__ void done(const Unit&) const {}
};
struct PairOrder : StaticOrder {
    const bf16_t *A20, *A21, *B20, *B21;
    __device__ bool next(int i, Unit& u) const { const bool r = StaticOrder::next(i >> 1, u); u.half = i & 1; return r; }
    __device__ __forceinline__ const char* baseA(const Gemm&, const Unit& u) const { return (const char*)(u.half ? A21 : A20); }
    __device__ __forceinline__ const char* baseB(const Gemm&, const Unit& u) const { return (const char*)(u.half ? B21 : B20); }
};

typedef float f32x2_t __attribute__((ext_vector_type(2))); typedef __bf16 bf16x2_t __attribute__((ext_vector_type(2)));
__device__ __forceinline__ unsigned cvtpk(float lo, float hi) { f32x2_t v = {lo, hi}; bf16x2_t b = __builtin_convertvector(v, bf16x2_t); return __builtin_bit_cast(unsigned, b); }
__device__ __forceinline__ float bflo(unsigned w) { return __uint_as_float(w << 16); }
__device__ __forceinline__ float bfhi(unsigned w) { return __uint_as_float(w & 0xffff0000u); }
__device__ __forceinline__ float sigmoidf_(float x) { return __builtin_amdgcn_rcpf(1.f + __builtin_amdgcn_exp2f(-1.4426950408889634f * x)); }
__device__ __forceinline__ float siluf_(float x) { return x * sigmoidf_(x); }


constexpr float QSCALE = 0.08838834764831845f * 1.4426950408889634f;

struct EpiProj {
    static constexpr bool PERM = true, AFTER_DRAIN = false, TWO_STAGE = false;
    bf16_t *Q, *Kb, *V, *HG; const float* invf;
    __device__ __forceinline__ void operator()(const f32x4 (&acc)[2][2][4][2], const Unit& u, int wr, int wc, int fr, int fq) const {
        const int row0 = u.pm * BM + wr * 64 + fr;
        if (u.pn < 24) {
            const bool isq = u.pn < 12; bf16_t* base = isq ? Q : Kb; const int pnl = isq ? u.pn : u.pn - 12; const float sc = isq ? QSCALE : 1.f;
            const int head = 2 * pnl + (wc >> 1), d0 = 32 * (wc & 1) + 8 * fq;
            const f32x4 fa = *(const f32x4*)(invf + d0), fb = *(const f32x4*)(invf + d0 + 4);
            const float fe[8] = {fa[0], fa[1], fa[2], fa[3], fb[0], fb[1], fb[2], fb[3]};
#pragma unroll
            for (int ai = 0; ai < 2; ++ai)
#pragma unroll
                for (int m = 0; m < 4; ++m) {
                    const int row = row0 + ai * HALF + m * 16, pos = row & 8191;
                    const float posf = (float)pos;
                    const f32x4 l0 = acc[ai][0][m][0], l1 = acc[ai][0][m][1], h0 = acc[ai][1][m][0], h1 = acc[ai][1][m][1];
                    float lo[8] = {l0[0], l0[1], l0[2], l0[3], l1[0], l1[1], l1[2], l1[3]};
                    float hi[8] = {h0[0], h0[1], h0[2], h0[3], h1[0], h1[1], h1[2], h1[3]};
                    float cs[8], sn[8];
#pragma unroll
                    for (int e = 0; e < 8; ++e) {
                        const float ang = posf * fe[e];
                        const float kq = __builtin_rintf(ang * 0.15915494309189535f);
                        float rr = __builtin_fmaf(-kq, 6.28125f, ang); rr = __builtin_fmaf(-kq, 1.9353071795864769e-3f, rr);
                        const float tt = rr * 0.15915494309189535f;
                        cs[e] = __builtin_amdgcn_cosf(tt); sn[e] = __builtin_amdgcn_sinf(tt);
                    }
                    float ol[8], oh[8];
#pragma unroll
                    for (int e = 0; e < 8; ++e) { ol[e] = (lo[e] * cs[e] - hi[e] * sn[e]) * sc; oh[e] = (hi[e] * cs[e] + lo[e] * sn[e]) * sc; }
                    bf16_t* rowp = base + (size_t)row * 3072 + head * 128 + d0;
                    u32x4 w; w.x = cvtpk(ol[0], ol[1]); w.y = cvtpk(ol[2], ol[3]); w.z = cvtpk(ol[4], ol[5]); w.w = cvtpk(ol[6], ol[7]);
                    *(u32x4*)rowp = w;
                    w.x = cvtpk(oh[0], oh[1]); w.y = cvtpk(oh[2], oh[3]); w.z = cvtpk(oh[4], oh[5]); w.w = cvtpk(oh[6], oh[7]);
                    *(u32x4*)(rowp + 64) = w;
                }
        } else {
            bf16_t* base; int ldc, colt;
            if (u.pn < 36) { base = V; ldc = 3072; colt = (u.pn - 24) * BM; } else { base = HG; ldc = 4096; colt = (u.pn - 36) * BM; }
            const int col0 = colt + wc * 32 + 8 * fq;
#pragma unroll
            for (int ai = 0; ai < 2; ++ai)
#pragma unroll
                for (int m = 0; m < 4; ++m) { bf16_t* rowp = base + (size_t)(row0 + ai * HALF + m * 16) * ldc + col0;
#pragma unroll
                    for (int bj = 0; bj < 2; ++bj) { const f32x4 v0 = acc[ai][bj][m][0], v1 = acc[ai][bj][m][1];
                        u32x4 w; w.x = cvtpk(v0[0], v0[1]); w.y = cvtpk(v0[2], v0[3]); w.z = cvtpk(v1[0], v1[1]); w.w = cvtpk(v1[2], v1[3]);
                        *(u32x4*)(rowp + bj * HALF) = w; } }
        }
    }
};
struct EpiPlain {
    static constexpr bool PERM = true, AFTER_DRAIN = false, TWO_STAGE = false;
    bf16_t* O; int ldc;
    __device__ __forceinline__ void operator()(const f32x4 (&acc)[2][2][4][2], const Unit& u, int wr, int wc, int fr, int fq) const {
        const int row0 = u.pm * BM + wr * 64 + fr, col0 = u.pn * BM + wc * 32 + 8 * fq;
#pragma unroll
        for (int ai = 0; ai < 2; ++ai)
#pragma unroll
            for (int m = 0; m < 4; ++m) { bf16_t* rowp = O + (size_t)(row0 + ai * HALF + m * 16) * ldc + col0;
#pragma unroll
                for (int bj = 0; bj < 2; ++bj) { const f32x4 v0 = acc[ai][bj][m][0], v1 = acc[ai][bj][m][1];
                    u32x4 w; w.x = cvtpk(v0[0], v0[1]); w.y = cvtpk(v0[2], v0[3]); w.z = cvtpk(v1[0], v1[1]); w.w = cvtpk(v1[2], v1[3]);
                    *(u32x4*)(rowp + bj * HALF) = w; } }
    }
};
template <bool ACCUM> struct EpiGate {
    static constexpr bool PERM = true, AFTER_DRAIN = false, TWO_STAGE = false;
    bf16_t* Y; const bf16_t* G; int goff;
    __device__ __forceinline__ void operator()(const f32x4 (&acc)[2][2][4][2], const Unit& u, int wr, int wc, int fr, int fq) const {
        const int row0 = u.pm * BM + wr * 64 + fr, col0 = u.pn * BM + wc * 32 + 8 * fq;
#pragma unroll
        for (int ai = 0; ai < 2; ++ai) {
            u32x4 gwv[4][2], ywv[4][2];
#pragma unroll
            for (int m = 0; m < 4; ++m)
#pragma unroll
                for (int bj = 0; bj < 2; ++bj) { const size_t row = (size_t)(row0 + ai * HALF + m * 16);
                    gwv[m][bj] = *(const u32x4*)(G + row * 4096 + goff + col0 + bj * HALF);
                    if (ACCUM) ywv[m][bj] = *(const u32x4*)(Y + row * 2048 + col0 + bj * HALF); }
#pragma unroll
            for (int m = 0; m < 4; ++m) { const size_t row = (size_t)(row0 + ai * HALF + m * 16);
#pragma unroll
                for (int bj = 0; bj < 2; ++bj) {
                    const u32x4 gw = gwv[m][bj];
                    bf16_t* yp = Y + row * 2048 + col0 + bj * HALF;
                    const f32x4 v0 = acc[ai][bj][m][0], v1 = acc[ai][bj][m][1];
                    float o[8] = {v0[0], v0[1], v0[2], v0[3], v1[0], v1[1], v1[2], v1[3]};
                    const unsigned gws[4] = {gw.x, gw.y, gw.z, gw.w};
#pragma unroll
                    for (int e = 0; e < 4; ++e) { o[2 * e] *= sigmoidf_(bflo(gws[e])); o[2 * e + 1] *= sigmoidf_(bfhi(gws[e])); }
                    if (ACCUM) { const u32x4 yw = ywv[m][bj]; const unsigned yws[4] = {yw.x, yw.y, yw.z, yw.w};
#pragma unroll
                        for (int e = 0; e < 4; ++e) { o[2 * e] += bflo(yws[e]); o[2 * e + 1] += bfhi(yws[e]); } }
                    u32x4 w; w.x = cvtpk(o[0], o[1]); w.y = cvtpk(o[2], o[3]); w.z = cvtpk(o[4], o[5]); w.w = cvtpk(o[6], o[7]);
                    *(u32x4*)yp = w; } }
        }
    }
};
struct EpiGate2 {
    static constexpr bool PERM = true, AFTER_DRAIN = false, TWO_STAGE = true;
    bf16_t* Y; const bf16_t* G;
    __device__ __forceinline__ void mid(f32x4 (&acc)[2][2][4][2], const Unit& u, int wr, int wc, int fr, int fq) const {
        const int row0 = u.pm * BM + wr * 64 + fr, col0 = u.pn * BM + wc * 32 + 8 * fq;
#pragma unroll
        for (int ai = 0; ai < 2; ++ai) {
            u32x4 gav[4][2], grv[4][2];
#pragma unroll
            for (int m = 0; m < 4; ++m)
#pragma unroll
                for (int bj = 0; bj < 2; ++bj) { const bf16_t* gp = G + (size_t)(row0 + ai * HALF + m * 16) * 4096 + col0 + bj * HALF;
                    gav[m][bj] = *(const u32x4*)gp; grv[m][bj] = *(const u32x4*)(gp + 2048); }
#pragma unroll
            for (int m = 0; m < 4; ++m)
#pragma unroll
                for (int bj = 0; bj < 2; ++bj) {
                    const unsigned gas[4] = {gav[m][bj].x, gav[m][bj].y, gav[m][bj].z, gav[m][bj].w}, grs[4] = {grv[m][bj].x, grv[m][bj].y, grv[m][bj].z, grv[m][bj].w};
#pragma unroll
                    for (int e = 0; e < 4; ++e) {
                        const float ea0 = __builtin_amdgcn_exp2f(-1.4426950408889634f * bflo(gas[e])), ea1 = __builtin_amdgcn_exp2f(-1.4426950408889634f * bfhi(gas[e]));
                        const float er0 = __builtin_amdgcn_exp2f(-1.4426950408889634f * bflo(grs[e])), er1 = __builtin_amdgcn_exp2f(-1.4426950408889634f * bfhi(grs[e]));
                        const float r0 = (1.f + er0) * __builtin_amdgcn_rcpf(1.f + ea0), r1 = (1.f + er1) * __builtin_amdgcn_rcpf(1.f + ea1);
                        acc[ai][bj][m][e >> 1][(2 * e) & 3] *= r0; acc[ai][bj][m][e >> 1][(2 * e + 1) & 3] *= r1;
                    }
                }
        }
    }
    __device__ __forceinline__ void operator()(const f32x4 (&acc)[2][2][4][2], const Unit& u, int wr, int wc, int fr, int fq) const {
        const int row0 = u.pm * BM + wr * 64 + fr, col0 = u.pn * BM + wc * 32 + 8 * fq;
#pragma unroll
        for (int ai = 0; ai < 2; ++ai) {
            u32x4 grv[4][2];
#pragma unroll
            for (int m = 0; m < 4; ++m)
#pragma unroll
                for (int bj = 0; bj < 2; ++bj) grv[m][bj] = *(const u32x4*)(G + (size_t)(row0 + ai * HALF + m * 16) * 4096 + 2048 + col0 + bj * HALF);
#pragma unroll
            for (int m = 0; m < 4; ++m)
#pragma unroll
                for (int bj = 0; bj < 2; ++bj) {
                    const f32x4 v0 = acc[ai][bj][m][0], v1 = acc[ai][bj][m][1];
                    float o[8] = {v0[0], v0[1], v0[2], v0[3], v1[0], v1[1], v1[2], v1[3]};
                    const unsigned grs[4] = {grv[m][bj].x, grv[m][bj].y, grv[m][bj].z, grv[m][bj].w};
#pragma unroll
                    for (int e = 0; e < 4; ++e) { o[2 * e] *= sigmoidf_(bflo(grs[e])); o[2 * e + 1] *= sigmoidf_(bfhi(grs[e])); }
                    u32x4 w; w.x = cvtpk(o[0], o[1]); w.y = cvtpk(o[2], o[3]); w.z = cvtpk(o[4], o[5]); w.w = cvtpk(o[6], o[7]);
                    *(u32x4*)(Y + (size_t)(row0 + ai * HALF + m * 16) * 2048 + col0 + bj * HALF) = w;
                }
        }
    }
};
struct EpiF32 {
    static constexpr bool PERM = false, AFTER_DRAIN = false, TWO_STAGE = false;
    float* O; int ldc;
    __device__ __forceinline__ void operator()(const f32x4 (&acc)[2][2][4][2], const Unit& u, int wr, int wc, int fr, int fq) const {
        const int row0 = u.pm * BM + wr * 64 + fr, col0 = u.pn * BM + wc * 32 + 4 * fq;
#pragma unroll
        for (int ai = 0; ai < 2; ++ai)
#pragma unroll
            for (int m = 0; m < 4; ++m) { float* rowp = O + (size_t)(row0 + ai * HALF + m * 16) * ldc + col0;
#pragma unroll
                for (int bj = 0; bj < 2; ++bj)
#pragma unroll
                    for (int n = 0; n < 2; ++n) *(f32x4*)(rowp + bj * HALF + n * 16) = acc[ai][bj][m][n]; }
    }
};
struct EpiSwiGLU {
    static constexpr bool PERM = true, AFTER_DRAIN = false, TWO_STAGE = false;
    bf16_t* O; int ldc; const float* rs;
    __device__ __forceinline__ void operator()(const f32x4 (&acc)[2][2][4][2], const Unit& u, int wr, int wc, int fr, int fq) const {
        const int row0 = u.pm * BM + wr * 64 + fr, col0 = u.pn * HALF + wc * 32 + 8 * fq;
        float rr[2][4];
#pragma unroll
        for (int ai = 0; ai < 2; ++ai)
#pragma unroll
            for (int m = 0; m < 4; ++m) rr[ai][m] = rs[row0 + ai * HALF + m * 16];
#pragma unroll
        for (int ai = 0; ai < 2; ++ai)
#pragma unroll
            for (int m = 0; m < 4; ++m) { bf16_t* rowp = O + (size_t)(row0 + ai * HALF + m * 16) * ldc + col0; const float r_ = rr[ai][m];
                const f32x4 g0 = acc[ai][0][m][0] * r_, g1 = acc[ai][0][m][1] * r_, u0 = acc[ai][1][m][0] * r_, u1 = acc[ai][1][m][1] * r_;
                float o[8];
#pragma unroll
                for (int e = 0; e < 4; ++e) { o[e] = siluf_(g0[e]) * u0[e]; o[4 + e] = siluf_(g1[e]) * u1[e]; }
                u32x4 w; w.x = cvtpk(o[0], o[1]); w.y = cvtpk(o[2], o[3]); w.z = cvtpk(o[4], o[5]); w.w = cvtpk(o[6], o[7]);
                *(u32x4*)rowp = w; }
    }
};

template <class Epi, class Sched, bool ALIGN_EPI = false, bool SP2 = false>
__device__ __forceinline__ void gemm_phase(PG8_LAS unsigned char* lds, const Gemm g, const Sched& S, const Epi& E) {
    int tid_ = threadIdx.x; asm volatile("" : "+v"(tid_));
    const int tid = tid_, wid = __builtin_amdgcn_readfirstlane(tid >> 6), lane = tid & 63, wr = wid >> 2, wc = wid & 3, fr = lane & 15, fq = lane >> 4;
    const int K = g.K, nt = K / BK;
    unsigned voffA[2], voffB[2];
#pragma unroll
    for (int i = 0; i < 2; ++i) { int R, C; stage_rc(tid * 16 + i * 8192, R, C); const int Rb = Epi::PERM ? ((R & ~31) + perm32(R & 31)) : R;
        voffA[i] = (unsigned)(R * g.lda + C) * 2u; voffB[i] = (unsigned)(Rb * g.ldb + C) * 2u; }
    const size_t kstep = (size_t)(BK * 2);
    const size_t hstepA = (size_t)HALF * g.lda * 2, hstepB = (size_t)HALF * g.ldb * 2;
    const size_t tstepA = 2 * hstepA, tstepB = 2 * hstepB;
    const unsigned ldsw = (unsigned)wid * 1024u;
    const int aoff = lds_byte(wr * 64 + fr, fq * 8), boff = lds_byte(wc * 32 + fr, fq * 8);
#define PG8_SA(b, h) (((b) * 2 + (h)) * HTB)
#define PG8_SB(b, h) ((4 + (b) * 2 + (h)) * HTB)
#define PG8_STAGE(bufoff, gbase, voff) do { _Pragma("unroll") for (int _i = 0; _i < 2; ++_i) \
        __builtin_amdgcn_global_load_lds((const unsigned*)((const char*)(gbase) + (voff)[_i]), (PG8_LAS unsigned*)(lds + (bufoff) + ldsw + _i * 8192), 16, 0, 0); } while (0)
#define PG8_LDA(dst, b, h) do { _Pragma("unroll") for (int m = 0; m < 4; ++m) _Pragma("unroll") for (int k = 0; k < 2; ++k) dst[m][k] = *(const PG8_LAS bf16x8*)(lds + PG8_SA(b, h) + aoff + m * 2048 + k * 1024); } while (0)
#define PG8_LDB(dst, b, h) do { _Pragma("unroll") for (int n = 0; n < 2; ++n) _Pragma("unroll") for (int k = 0; k < 2; ++k) dst[n][k] = *(const PG8_LAS bf16x8*)(lds + PG8_SB(b, h) + boff + n * 2048 + k * 1024); } while (0)
#define PG8_MMA(ai, bj, At, Bt) do { __builtin_amdgcn_s_setprio(1); _Pragma("unroll") for (int m = 0; m < 4; ++m) _Pragma("unroll") for (int n = 0; n < 2; ++n) _Pragma("unroll") for (int k = 0; k < 2; ++k) \
        acc[ai][bj][m][n] = __builtin_amdgcn_mfma_f32_16x16x32_bf16(Bt[n][k], At[m][k], acc[ai][bj][m][n], 0, 0, 0); __builtin_amdgcn_s_setprio(0); } while (0)
#define PG8_WAIT_V(n) asm volatile("s_waitcnt vmcnt(" #n ")" ::: "memory")
#define PG8_WAIT_L(n) asm volatile("s_waitcnt lgkmcnt(" #n ")" ::: "memory")
#define PG8_BAR __builtin_amdgcn_s_barrier()
#define PG8_SCHED __builtin_amdgcn_sched_barrier(0)
    Unit cur, nxt; int ui = 0;
    if (!S.next(0, cur)) return;
    f32x4 acc[2][2][4][2];
#pragma unroll
    for (int a = 0; a < 2; ++a)
#pragma unroll
        for (int b = 0; b < 2; ++b)
#pragma unroll
            for (int m = 0; m < 4; ++m)
#pragma unroll
                for (int n = 0; n < 2; ++n) acc[a][b][m][n] = (f32x4){0.f, 0.f, 0.f, 0.f};
    bf16x8 At[4][2], B0[2][2], B1[2][2];
    const char* cA = S.baseA(g, cur) + (size_t)cur.pm * tstepA; const char* cB = S.baseB(g, cur) + (size_t)cur.pn * tstepB;
    S.a_ready(cur);
    if constexpr (SP2) {
        PG8_STAGE(PG8_SB(0, 0), cB, voffB); PG8_STAGE(PG8_SB(0, 1), cB + hstepB, voffB); PG8_STAGE(PG8_SA(0, 0), cA, voffA); PG8_STAGE(PG8_SA(0, 1), cA + hstepA, voffA);
        if (wr == 1) PG8_BAR;
        PG8_WAIT_V(2); PG8_BAR;
        PG8_STAGE(PG8_SB(1, 0), cB + kstep, voffB); PG8_STAGE(PG8_SA(1, 0), cA + kstep, voffA); PG8_STAGE(PG8_SB(1, 1), cB + hstepB + kstep, voffB);
        PG8_WAIT_V(6); PG8_BAR;
    } else {
        PG8_STAGE(PG8_SB(0, 0), cB, voffB); PG8_STAGE(PG8_SA(0, 0), cA, voffA); PG8_STAGE(PG8_SB(0, 1), cB + hstepB, voffB); PG8_STAGE(PG8_SA(0, 1), cA + hstepA, voffA);
        if (wr == 1) PG8_BAR;
        PG8_WAIT_V(4); PG8_BAR;
        PG8_STAGE(PG8_SB(1, 0), cB + kstep, voffB); PG8_STAGE(PG8_SA(1, 0), cA + kstep, voffA); PG8_STAGE(PG8_SB(1, 1), cB + hstepB + kstep, voffB);
        PG8_WAIT_V(6); PG8_BAR;
    }
    for (;;) {
        const bool has_next = S.next(ui + 1, nxt);
        const char* nA = has_next ? S.baseA(g, nxt) + (size_t)nxt.pm * tstepA : cA; const char* nB = has_next ? S.baseB(g, nxt) + (size_t)nxt.pn * tstepB : cB;
        for (int t = 0; t < nt; t += 2) {
            const bool last = (t == nt - 2);
            const char* a1 = cA + (size_t)(t + 1) * kstep;
            const char* a2 = last ? nA : cA + (size_t)(t + 2) * kstep; const char* b2 = last ? nB : cB + (size_t)(t + 2) * kstep;
            const char* a3 = a2 + kstep; const char* b3 = b2 + kstep;
            if (last && has_next) S.a_ready(nxt);
            if constexpr (SP2) {
            PG8_LDB(B0, 0, 0); PG8_LDB(B1, 0, 1); PG8_SCHED; PG8_LDA(At, 0, 0); PG8_STAGE(PG8_SA(1, 1), a1 + hstepA, voffA);
            PG8_WAIT_V(8); PG8_WAIT_L(0); PG8_BAR; PG8_MMA(0, 0, At, B0); PG8_MMA(0, 1, At, B1); PG8_BAR; PG8_SCHED;
            PG8_LDA(At, 0, 1); PG8_STAGE(PG8_SB(0, 0), b2, voffB); PG8_STAGE(PG8_SB(0, 1), b2 + hstepB, voffB); PG8_STAGE(PG8_SA(0, 0), a2, voffA);
            PG8_WAIT_V(8); PG8_WAIT_L(0); PG8_BAR; PG8_MMA(1, 0, At, B0); PG8_MMA(1, 1, At, B1); PG8_BAR; PG8_SCHED;
            PG8_LDB(B0, 1, 0); PG8_LDB(B1, 1, 1); PG8_SCHED; PG8_LDA(At, 1, 0); PG8_STAGE(PG8_SA(0, 1), a2 + hstepA, voffA);
            PG8_WAIT_V(8); PG8_WAIT_L(0); PG8_BAR; PG8_MMA(0, 0, At, B0); PG8_MMA(0, 1, At, B1); PG8_BAR; PG8_SCHED;
            PG8_LDA(At, 1, 1); PG8_STAGE(PG8_SB(1, 0), b3, voffB); PG8_STAGE(PG8_SB(1, 1), b3 + hstepB, voffB); PG8_STAGE(PG8_SA(1, 0), a3, voffA);
            PG8_WAIT_V(8); PG8_WAIT_L(0); PG8_BAR; PG8_MMA(1, 0, At, B0); PG8_MMA(1, 1, At, B1); PG8_BAR; PG8_SCHED;
            } else {
            PG8_LDB(B0, 0, 0); PG8_SCHED; PG8_LDA(At, 0, 0); PG8_STAGE(PG8_SA(1, 1), a1 + hstepA, voffA);
            PG8_WAIT_L(8); PG8_BAR; PG8_WAIT_L(0); PG8_MMA(0, 0, At, B0); PG8_BAR; PG8_SCHED;
            PG8_LDB(B1, 0, 1); PG8_STAGE(PG8_SB(0, 0), b2, voffB);
            PG8_BAR; PG8_WAIT_L(0); PG8_MMA(0, 1, At, B1); PG8_BAR;
            PG8_LDA(At, 0, 1); PG8_STAGE(PG8_SA(0, 0), a2, voffA);
            PG8_BAR; PG8_WAIT_L(0); PG8_MMA(1, 0, At, B0); PG8_BAR; PG8_SCHED;
            PG8_STAGE(PG8_SB(0, 1), b2 + hstepB, voffB);
            PG8_WAIT_V(6); PG8_BAR; PG8_MMA(1, 1, At, B1); PG8_BAR;
            PG8_LDB(B0, 1, 0); PG8_SCHED; PG8_LDA(At, 1, 0); PG8_STAGE(PG8_SA(0, 1), a2 + hstepA, voffA);
            PG8_WAIT_L(8); PG8_BAR; PG8_WAIT_L(0); PG8_MMA(0, 0, At, B0); PG8_BAR; PG8_SCHED;
            PG8_LDB(B1, 1, 1); PG8_STAGE(PG8_SB(1, 0), b3, voffB);
            PG8_BAR; PG8_WAIT_L(0); PG8_MMA(0, 1, At, B1); PG8_BAR;
            PG8_LDA(At, 1, 1); PG8_STAGE(PG8_SA(1, 0), a3, voffA);
            PG8_BAR; PG8_WAIT_L(0); PG8_MMA(1, 0, At, B0); PG8_BAR; PG8_SCHED;
            PG8_STAGE(PG8_SB(1, 1), b3 + hstepB, voffB);
            PG8_WAIT_V(6); PG8_BAR; PG8_MMA(1, 1, At, B1); PG8_BAR;
            }
        }
        if constexpr (ALIGN_EPI) { if (wr == 0) PG8_BAR; }
        bool keep_acc = false;
        if constexpr (Epi::TWO_STAGE) { if (cur.half == 0) { E.mid(acc, cur, wr, wc, fr, fq); keep_acc = true; } else E(acc, cur, wr, wc, fr, fq); }
        else if constexpr (!Epi::AFTER_DRAIN) { E(acc, cur, wr, wc, fr, fq); S.done(cur); }
        if (!has_next) break;
        if (!keep_acc)
#pragma unroll
        for (int a = 0; a < 2; ++a)
#pragma unroll
            for (int b = 0; b < 2; ++b)
#pragma unroll
                for (int m = 0; m < 4; ++m)
#pragma unroll
                    for (int n = 0; n < 2; ++n) acc[a][b][m][n] = (f32x4){0.f, 0.f, 0.f, 0.f};
        cur = nxt; cA = nA; cB = nB; ++ui;
        if constexpr (ALIGN_EPI) { if (wr == 1) PG8_BAR; }
    }
    PG8_WAIT_V(0);
    if constexpr (!ALIGN_EPI) { if (wr == 0) PG8_BAR; }
    PG8_BAR;
#undef PG8_SA
#undef PG8_SB
#undef PG8_STAGE
#undef PG8_LDA
#undef PG8_LDB
#undef PG8_MMA
#undef PG8_WAIT_V
#undef PG8_WAIT_L
#undef PG8_BAR
#undef PG8_SCHED
}
}

using pg8::bf16_t; using pg8::bf16x8; using pg8::f32x4; using pg8::u32x4; using pg8::u32x2; using pg8::cvtpk; using pg8::bflo; using pg8::bfhi; using pg8::sigmoidf_; using pg8::siluf_;
typedef float f32x16 __attribute__((ext_vector_type(16)));
typedef short s16x4 __attribute__((ext_vector_type(4)));
typedef short v4i16_t __attribute__((ext_vector_type(4)));
#define LAS __attribute__((address_space(3)))
#define MFMA32(a, b, c) __builtin_amdgcn_mfma_f32_32x32x16_bf16((a), (b), (c), 0, 0, 0)

constexpr int NWAVES = 8, NTHR = 512;
constexpr int MTOK = 16384, DM = 2048, SEQ = 8192, DFF = 5632, NIN = 17408;
constexpr float EPS = 1e-6f;
constexpr size_t MiB = 1u << 20;
constexpr size_t WS_BAR = 65536, WS_BAR_BYTES = 16384;
constexpr size_t WS_R2 = 327680;
constexpr size_t WS_RSTD0 = 262144;
constexpr size_t WS_LB = 0, WS_LSE = 1 * MiB, WS_DEC = 3 * MiB, WS_ROPE = 4 * MiB, WS_WIN = 8 * MiB, WS_XN = 76 * MiB, WS_Q = 140 * MiB, WS_K = 236 * MiB, WS_V = 332 * MiB, WS_S = 428 * MiB;
constexpr size_t WS_WPA = 8 * MiB, WS_WPR = 12 * MiB, WS_WO = 16 * MiB, WS_WDN = 24 * MiB;
constexpr size_t WS_WING = WS_WIN + (size_t)13312 * 2048 * 2;
constexpr size_t WS_G = 236 * MiB, WS_WGU = 364 * MiB;
constexpr size_t WS_Y = WS_S, WS_Z = 236 * MiB, WS_A2 = WS_XN, WS_FFH = 140 * MiB, WS_Z2 = 316 * MiB;
constexpr size_t WS_END = 492 * MiB;
constexpr int LDS_BYTES = 147456;

struct Args { const float* in[13]; float* out; unsigned char* ws; float inv_freq[64]; };

__device__ __forceinline__ int crow(int reg, int h) { return (reg & 3) + 8 * (reg >> 2) + 4 * h; }
__device__ __forceinline__ float wave_sum(float v) {
#pragma unroll
    for (int o = 1; o < 64; o <<= 1) v += __shfl_xor(v, o);
    return v;
}
__device__ __forceinline__ bf16x8 pack8(const f32x16& x, int s8) {
    u32x4 p; p.x = cvtpk(x[s8 + 0], x[s8 + 1]); p.y = cvtpk(x[s8 + 2], x[s8 + 3]); p.z = cvtpk(x[s8 + 4], x[s8 + 5]); p.w = cvtpk(x[s8 + 6], x[s8 + 7]);
    return __builtin_bit_cast(bf16x8, p);
}
__device__ __forceinline__ s16x4 trd(const LAS unsigned char* p) { return __builtin_bit_cast(s16x4, __builtin_amdgcn_ds_read_tr16_b64_v4i16((LAS v4i16_t*)p)); }


#define XB_TMO      128
#define XB_XCNT(j)  (256  + 64 * (j))
#define XB_XSUB(j)  (1280 + 64 * (j))
#define XB_XGEN(j)  (2304 + 64 * (j))
#define XB_TOP      3328
#define XB_TOPGEN   3392
#define XCD_BAR_WORDS 3456
#define XB_SPIN_CAP (1u << 20)
__device__ __forceinline__ unsigned xb_ld(unsigned* p)              { return __hip_atomic_load(p, __ATOMIC_RELAXED, __HIP_MEMORY_SCOPE_AGENT); }
__device__ __forceinline__ unsigned xb_add(unsigned* p, unsigned v) { return __hip_atomic_fetch_add(p, v, __ATOMIC_RELAXED, __HIP_MEMORY_SCOPE_AGENT); }
__device__ __forceinline__ unsigned xb_xcc_id() { return (unsigned)__builtin_amdgcn_s_getreg((3 << 11) | 20) & 0xFu; }
#define XB_SPIN(cond, bar) do { unsigned _sp = 0; while (cond) { \
    if ((++_sp & 255u) == 0u) { if (xb_ld(&(bar)[XB_TMO])) break; if (_sp > XB_SPIN_CAP) { atomicAdd(&(bar)[XB_TMO], 1u); break; } } } } while (0)
struct XcdBarrier { unsigned* bar; unsigned x; volatile LAS unsigned* st; };
__device__ __forceinline__ XcdBarrier xcd_barrier_post(unsigned* bar, volatile LAS unsigned* st) {
    XcdBarrier b; b.bar = bar; b.x = xb_xcc_id(); b.st = st;
    if (threadIdx.x == 0) (void)xb_add(&bar[XB_XCNT(b.x)], 1u);
    return b;
}
__device__ __forceinline__ void xcd_barrier_complete(unsigned* bar, unsigned x, unsigned& nloc, unsigned& nx) {
    const unsigned G = gridDim.x * gridDim.y * gridDim.z;
    unsigned sum, cnt, mine, sp = 0u;
    for (;;) {
        sum = 0u; cnt = 0u; mine = 0u;
#pragma unroll
        for (unsigned j = 0; j < 16; ++j) { const unsigned c = xb_ld(&bar[XB_XCNT(j)]); sum += c; cnt += (c > 0u) ? 1u : 0u; mine = (j == x) ? c : mine; }
        if (sum == G) break;
        __builtin_amdgcn_s_sleep(1);
        if ((++sp & 255u) == 0u) { if (xb_ld(&bar[XB_TMO])) break; if (sp > XB_SPIN_CAP) { atomicAdd(&bar[XB_TMO], 1u); break; } }
    }
    nloc = mine > 0u ? mine : 1u; nx = cnt > 0u ? cnt : 1u;
}
__device__ __forceinline__ void xcd_barrier(const XcdBarrier& b) {
    asm volatile("s_waitcnt vmcnt(0)" ::: "memory");
    __syncthreads();
    if (threadIdx.x == 0) {
        unsigned* bar = b.bar;
        __builtin_amdgcn_s_waitcnt(0);
        unsigned nloc = b.st[0], nx = b.st[1];
        if (nloc == 0u) { xcd_barrier_complete(bar, b.x, nloc, nx); b.st[0] = nloc; b.st[1] = nx; }
        const unsigned old = xb_add(&bar[XB_XSUB(b.x)], 1u);
        const unsigned gen = old / nloc;
        if (old + 1u == (gen + 1u) * nloc) {
            __builtin_amdgcn_fence(__ATOMIC_RELEASE, "agent");
            asm volatile("s_waitcnt vmcnt(0)" ::: "memory");
            const unsigned og = xb_add(&bar[XB_TOP], 1u);
            const unsigned tg = og / nx;
            if (og + 1u == (tg + 1u) * nx) xb_add(&bar[XB_TOPGEN], 1u);
            else XB_SPIN(xb_ld(&bar[XB_TOPGEN]) == tg, bar);
            __builtin_amdgcn_fence(__ATOMIC_ACQUIRE, "agent");
            xb_add(&bar[XB_XGEN(b.x)], 1u);
            asm volatile("s_waitcnt vmcnt(0)" ::: "memory");
        } else {
            XB_SPIN(xb_ld(&bar[XB_XGEN(b.x)]) == gen, bar);
            __builtin_amdgcn_fence(__ATOMIC_ACQUIRE, "agent");
            asm volatile("s_waitcnt vmcnt(0)" ::: "memory");
        }
    }
    __syncthreads();
}

template <int MODE> __device__ __forceinline__ int wmap(int n) {
    if (MODE == 1) { if (n < 6144) { const int pn = n >> 8, x = n & 255, hh = x >> 7, dd = x & 127, bj = dd >> 6, dl = dd & 63; return (pn << 8) + (bj << 7) + (hh << 6) + dl; } return n; }
    if (MODE == 2) { const int up = n >= DFF ? 1 : 0; const int j = up ? n - DFF : n; return ((j >> 7) << 8) + (up << 7) + (j & 127); }
    return n;
}
template <int MODE> __device__ __forceinline__ void transpose_load(const float* W, int N, int item, int lane, float (&v)[32]) {
    const int nblk = N / 32, kb = item / nblk, nb = item % nblk, k0 = 64 * kb, n0 = 32 * nb;
    const float* p = W + (size_t)(k0 + (lane >> 5)) * N + n0 + (lane & 31);
#pragma unroll
    for (int i = 0; i < 32; ++i) v[i] = p[(size_t)(2 * i) * N];
}
template <int MODE> __device__ __forceinline__ void transpose_store(const float (&v)[32], int K, int N, bf16_t* WT, LAS float* scr, int item, int lane, const float* ksc) {
    const int nblk = N / 32, kb = item / nblk, nb = item % nblk, k0 = 64 * kb, n0 = 32 * nb;
#pragma unroll
    for (int i = 0; i < 32; ++i) { const int kk = 2 * i + (lane >> 5); scr[kk * 33 + (lane & 31)] = v[i]; }
    asm volatile("s_waitcnt lgkmcnt(0)" ::: "memory");
    const int c = lane & 7; const int d0 = wmap<MODE>(n0);
    f32x4 ka = (f32x4){1.f, 1.f, 1.f, 1.f}, kb_ = ka;
    if (MODE == 2) { ka = *(const f32x4*)(ksc + k0 + 8 * c); kb_ = *(const f32x4*)(ksc + k0 + 8 * c + 4); }
#pragma unroll
    for (int j = 0; j < 4; ++j) { const int n = (lane >> 3) + 8 * j; const LAS float* s = scr + (8 * c) * 33 + n;
        u32x4 o; o.x = cvtpk(s[0 * 33] * ka[0], s[1 * 33] * ka[1]); o.y = cvtpk(s[2 * 33] * ka[2], s[3 * 33] * ka[3]); o.z = cvtpk(s[4 * 33] * kb_[0], s[5 * 33] * kb_[1]); o.w = cvtpk(s[6 * 33] * kb_[2], s[7 * 33] * kb_[3]);
        *(u32x4*)(WT + (size_t)(d0 + n) * K + k0 + 8 * c) = o; }
    asm volatile("s_waitcnt lgkmcnt(0)" ::: "memory");
}
template <int MODE> __device__ __forceinline__ void transpose_all(const float* W, int K, int N, bf16_t* WT, LAS unsigned char* lds, int gw, int ngw, int wave, int lane, const float* ksc = nullptr) {
    LAS float* scr = (LAS float*)(lds + wave * 16384);
    const int nitems = (K / 64) * (N / 32);
    float cur[32], nxt[32];
    if (gw < nitems) transpose_load<MODE>(W, N, gw, lane, cur);
    for (int it = gw; it < nitems; it += ngw) {
        const bool more = it + ngw < nitems;
        if (more) transpose_load<MODE>(W, N, it + ngw, lane, nxt);
        transpose_store<MODE>(cur, K, N, WT, scr, it, lane, ksc);
        if (more) {
#pragma unroll
            for (int i = 0; i < 32; ++i) cur[i] = nxt[i];
        }
    }
}

__device__ __forceinline__ void attn_unit(LAS unsigned char* lds, int a, const bf16_t* Qm, const bf16_t* Km, const bf16_t* Vm, bf16_t* Om, float* lse) {
    const int tid = threadIdx.x, lane = tid & 63, wid = __builtin_amdgcn_readfirstlane(tid >> 6), r = lane & 31, h = lane >> 5;
    const int g = a >> 10; int rem = a & 1023; const int b = rem >> 9; rem &= 511; const int hd = rem >> 6, blk = rem & 63;
    const int dsh = 2 * g, nsh = 6 - dsh;
    const int res = blk >> nsh, ub = blk & ((1 << nsh) - 1), u0 = ub * 128;
    const int col = (g * 8 + hd) * 128;
    const size_t rowbase = (size_t)b * SEQ + res;
    LAS unsigned char* Ks = lds; LAS unsigned char* Vs = lds + 65536;
    const int kk_lo = (u0 == 0) ? 128 : 0;
    {
        u32x4 kvr[8], vvr[8];
#pragma unroll
        for (int i = 0; i < 8; ++i) {
            const int idx = tid + 512 * i, kk = idx >> 4, c = idx & 15;
            const int uu = u0 - 128 + (kk < kk_lo ? kk_lo : kk);
            const size_t grow = rowbase + ((size_t)uu << dsh);
            kvr[i] = *(const u32x4*)(Km + grow * 3072 + col + c * 8);
            vvr[i] = *(const u32x4*)(Vm + grow * 3072 + col + c * 8);
        }
#pragma unroll
        for (int i = 0; i < 8; ++i) {
            const int idx = tid + 512 * i, kk = idx >> 4, c = idx & 15;
            *(LAS u32x4*)(Ks + kk * 256 + ((c ^ (kk & 15)) << 4)) = kvr[i];
            *(LAS u32x4*)(Vs + kk * 256 + (((c >> 1) ^ (kk & 7)) << 5) + ((c & 1) << 4)) = vvr[i];
        }
    }
    const int qj = lane & 15, qd = lane >> 4;
    const size_t qrow = rowbase + ((size_t)(u0 + 16 * wid + qj) << dsh);
    bf16x8 qf[4];
#pragma unroll
    for (int ks = 0; ks < 4; ++ks) qf[ks] = __builtin_bit_cast(bf16x8, *(const u32x4*)(Qm + qrow * 3072 + col + 32 * ks + 8 * qd));
    __syncthreads();
    f32x4 sc[9];
    const int tskip = (u0 == 0) ? (8 - wid) : 0;
#pragma unroll
    for (int t = 0; t < 9; ++t) {
        f32x4 acc = (f32x4){0.f, 0.f, 0.f, 0.f};
        if (t >= tskip) {
            const int kr = 16 * wid + 16 * t + qj;
#pragma unroll
            for (int ks = 0; ks < 4; ++ks) { const bf16x8 kf = *(const LAS bf16x8*)(Ks + kr * 256 + (((4 * ks + qd) ^ (kr & 15)) << 4)); acc = __builtin_amdgcn_mfma_f32_16x16x32_bf16(kf, qf[ks], acc, 0, 0, 0); }
        } else acc = (f32x4){-INFINITY, -INFINITY, -INFINITY, -INFINITY};
        sc[t] = acc;
    }
#pragma unroll
    for (int e = 0; e < 4; ++e) { if (4 * qd + e < qj) sc[0][e] = -INFINITY; if (4 * qd + e > qj) sc[8][e] = -INFINITY; }
    float mx = sc[8][0];
#pragma unroll
    for (int t = 0; t < 9; ++t)
#pragma unroll
        for (int e = 0; e < 4; ++e) mx = fmaxf(mx, sc[t][e]);
    mx = fmaxf(mx, __shfl_xor(mx, 16)); mx = fmaxf(mx, __shfl_xor(mx, 32));
    float l = 0.f;
#pragma unroll
    for (int t = 0; t < 9; ++t)
#pragma unroll
        for (int e = 0; e < 4; ++e) { sc[t][e] = __builtin_amdgcn_exp2f(sc[t][e] - mx); l += sc[t][e]; }
    l += __shfl_xor(l, 16); l += __shfl_xor(l, 32);
    f32x4 o[8];
#pragma unroll
    for (int db = 0; db < 8; ++db) o[db] = (f32x4){0.f, 0.f, 0.f, 0.f};
    const int q4 = (lane & 15) >> 2, p4 = lane & 3;
#pragma unroll
    for (int st = 0; st < 5; ++st) {
        if (2 * st + 1 < tskip) continue;
        u32x4 pw; pw.x = cvtpk(sc[2 * st][0], sc[2 * st][1]); pw.y = cvtpk(sc[2 * st][2], sc[2 * st][3]);
        if (st < 4) { pw.z = cvtpk(sc[2 * st + 1][0], sc[2 * st + 1][1]); pw.w = cvtpk(sc[2 * st + 1][2], sc[2 * st + 1][3]); } else { pw.z = 0u; pw.w = 0u; }
        const bf16x8 pb = __builtin_bit_cast(bf16x8, pw);
        const int key0 = 16 * wid + 32 * st + 4 * qd + q4;
        const int key1 = (st < 4) ? key0 + 16 : key0;
#pragma unroll
        for (int db = 0; db < 8; ++db) {
            const int so = ((db ^ (key0 & 7)) << 5) + 8 * p4;
            const s16x4 lo = trd(Vs + key0 * 256 + so), hi = trd(Vs + key1 * 256 + so);
            const bf16x8 af = __builtin_shufflevector(lo, hi, 0, 1, 2, 3, 4, 5, 6, 7);
            o[db] = __builtin_amdgcn_mfma_f32_16x16x32_bf16(af, pb, o[db], 0, 0, 0);
        }
    }
    const float inv = 1.f / l;
    __syncthreads();
    LAS unsigned char* stg = lds + wid * 4608;
#pragma unroll
    for (int db = 0; db < 8; ++db) {
        u32x2 w; w.x = cvtpk(o[db][0] * inv, o[db][1] * inv); w.y = cvtpk(o[db][2] * inv, o[db][3] * inv);
        *(LAS u32x2*)(stg + qj * 272 + (16 * db + 4 * qd) * 2) = w;
    }
    asm volatile("s_waitcnt lgkmcnt(0)" ::: "memory");
#pragma unroll
    for (int ps = 0; ps < 4; ++ps) {
        const int row = ps * 4 + (lane >> 4), ch = lane & 15;
        const u32x4 v = *(const LAS u32x4*)(stg + row * 272 + ch * 16);
        const size_t grow = rowbase + ((size_t)(u0 + 16 * wid + row) << dsh);
        *(u32x4*)(Om + grow * 3072 + col + ch * 8) = v;
    }
    if (qd == 0) lse[((size_t)g * MTOK + qrow) * 8 + hd] = mx + __builtin_amdgcn_logf(l);
    __syncthreads();
}

constexpr int HL_GB = 0, HL_PP = 33024, HL_RED = 35072, HL_QT = 36864, HL_KT = 53248, HL_KHT = 69632, HL_VT = 86016, HL_STG = 102400;
template <bool PASS_A> __device__ __forceinline__ void hgrn_setup(LAS unsigned char* lds, int b, int hd, int c, const bf16_t* HG, const float* LB) {
    const int tid = threadIdx.x;
    LAS float* GB = (LAS float*)(lds + HL_GB); LAS float* PP = (LAS float*)(lds + HL_PP);
    const size_t row0 = (size_t)b * SEQ + (size_t)c * 64;
#pragma unroll
    for (int i = 0; i < 2; ++i) {
        const int q = tid + 512 * i, t = q >> 4, cc = q & 15;
        const bf16_t* rp = HG + (row0 + t) * 4096 + hd * 128 + cc * 8;
        const u32x4 fw = *(const u32x4*)(rp + 1024), iw = *(const u32x4*)(rp + 2048);
        if (!PASS_A) { const u32x4 qw = *(const u32x4*)(rp); *(LAS u32x4*)(lds + HL_QT + t * 256 + ((cc ^ (t & 15)) << 4)) = qw; }
        *(LAS u32x4*)(lds + HL_KT + t * 256 + ((cc ^ (t & 15)) << 4)) = fw;
        *(LAS u32x4*)(lds + HL_STG + t * 272 + cc * 16) = iw;
    }
    __syncthreads();
    float omr[2][8];
#pragma unroll
    for (int i = 0; i < 2; ++i) {
        const int q = tid + 512 * i, t = q & 63, cc = q >> 6;
        const u32x4 fw = *(const LAS u32x4*)(lds + HL_KT + t * 256 + ((cc ^ (t & 15)) << 4));
        const unsigned fws[4] = {fw.x, fw.y, fw.z, fw.w};
#pragma unroll
        for (int e = 0; e < 8; ++e) {
            const float x = (e & 1) ? bfhi(fws[e >> 1]) : bflo(fws[e >> 1]);
            const float lbv = LB[hd * 128 + cc * 8 + e];
            const float ef = __builtin_amdgcn_exp2f(-1.4426950408889634f * x), sg = __builtin_amdgcn_rcpf(1.f + ef);
            const float f = lbv + (1.f - lbv) * sg;
            omr[i][e] = (1.f - lbv) * ef * sg;
            GB[t * 129 + cc * 8 + e] = __builtin_amdgcn_logf(f);
        }
    }
    __syncthreads();
    {
        const int k = tid & 127, part = tid >> 7; float accv = 0.f;
#pragma unroll
        for (int j = 0; j < 16; ++j) { const int t = 16 * part + j; accv += GB[t * 129 + k]; GB[t * 129 + k] = accv; }
        PP[part * 128 + k] = accv;
        __syncthreads();
        float off = 0.f;
        for (int pp = 0; pp < part; ++pp) off += PP[pp * 128 + k];
        if (part > 0) {
#pragma unroll
            for (int j = 0; j < 16; ++j) { const int t = 16 * part + j; GB[t * 129 + k] += off; }
        }
        if (part == 0) ((LAS float*)(lds + HL_RED))[k] = (PP[k] + PP[128 + k]) + (PP[256 + k] + PP[384 + k]);
    }
    __syncthreads();
#pragma unroll
    for (int i = 0; i < 2; ++i) {
        const int q = tid + 512 * i, t = q & 63, cc = q >> 6;
        const u32x4 qw = *(const LAS u32x4*)(lds + HL_QT + t * 256 + ((cc ^ (t & 15)) << 4)), fw = *(const LAS u32x4*)(lds + HL_KT + t * 256 + ((cc ^ (t & 15)) << 4)),
                    iw = *(const LAS u32x4*)(lds + HL_STG + t * 272 + cc * 16);
        const unsigned qws[4] = {qw.x, qw.y, qw.z, qw.w}, fws[4] = {fw.x, fw.y, fw.z, fw.w}, iws[4] = {iw.x, iw.y, iw.z, iw.w};
        float qt[8], kt[8];
#pragma unroll
        for (int e = 0; e < 8; ++e) {
            const int k = cc * 8 + e;
            const float bb = GB[t * 129 + k];
            const float om = omr[i][e];
            if (PASS_A) {
                const float bl = ((const LAS float*)(lds + HL_RED))[k];
                const float kh = om * __builtin_amdgcn_exp2f(bl - bb);
                const unsigned khb = cvtpk(kh, 0.f) & 0xffffu;
                *(LAS unsigned short*)(lds + HL_KHT + k * 128 + (((t >> 3) ^ (k & 7)) << 4) + (t & 7) * 2) = (unsigned short)khb;
            } else {
                const float qx = (e & 1) ? bfhi(qws[e >> 1]) : bflo(qws[e >> 1]);
                const float eb = __builtin_amdgcn_exp2f(bb), eq1 = 1.f + __builtin_amdgcn_exp2f(-1.4426950408889634f * qx);
                const float rr = __builtin_amdgcn_rcpf(eb * eq1);
                qt[e] = qx * eb * (rr * eb);
                kt[e] = om * (rr * eq1);
            }
            const unsigned iv = (e & 1) ? (iws[e >> 1] >> 16) : (iws[e >> 1] & 0xffffu);
            *(LAS unsigned short*)(lds + HL_VT + k * 128 + (((t >> 3) ^ (k & 7)) << 4) + (t & 7) * 2) = (unsigned short)iv;
        }
        if (!PASS_A) {
            u32x4 w; w.x = cvtpk(qt[0], qt[1]); w.y = cvtpk(qt[2], qt[3]); w.z = cvtpk(qt[4], qt[5]); w.w = cvtpk(qt[6], qt[7]);
            *(LAS u32x4*)(lds + HL_QT + t * 256 + ((cc ^ (t & 15)) << 4)) = w;
            w.x = cvtpk(kt[0], kt[1]); w.y = cvtpk(kt[2], kt[3]); w.z = cvtpk(kt[4], kt[5]); w.w = cvtpk(kt[6], kt[7]);
            *(LAS u32x4*)(lds + HL_KT + t * 256 + ((cc ^ (t & 15)) << 4)) = w;
        }
    }
    __syncthreads();
}
__device__ __forceinline__ void hgrn_pass_a(LAS unsigned char* lds, int unit, const bf16_t* HG, const float* LB, bf16_t* S, float* DEC) {
    const int tid = threadIdx.x, lane = tid & 63, wid = __builtin_amdgcn_readfirstlane(tid >> 6), r = lane & 31, h = lane >> 5;
    const int b = unit >> 10, hd = (unit >> 7) & 7, c = unit & 127;
    hgrn_setup<true>(lds, b, hd, c, HG, LB);
    const int vb = wid >> 1;
    bf16_t* Sg = S + (size_t)unit * 16384;
#pragma unroll
    for (int kbi = 0; kbi < 2; ++kbi) {
        const int kb = 2 * (wid & 1) + kbi;
        f32x16 acc;
#pragma unroll
        for (int i = 0; i < 16; ++i) acc[i] = 0.f;
        const int v = 32 * vb + r, k = 32 * kb + r;
#pragma unroll
        for (int ts = 0; ts < 4; ++ts) {
            const int ch = 2 * ts + h;
            const bf16x8 af = *(const LAS bf16x8*)(lds + HL_VT + v * 128 + ((ch ^ (v & 7)) << 4));
            const bf16x8 bf = *(const LAS bf16x8*)(lds + HL_KHT + k * 128 + ((ch ^ (k & 7)) << 4));
            acc = MFMA32(af, bf, acc);
        }
#pragma unroll
        for (int i = 0; i < 16; ++i) *(LAS unsigned short*)(lds + HL_GB + (32 * vb + crow(i, h)) * 256 + k * 2) = (unsigned short)(cvtpk(acc[i], 0.f) & 0xffffu);
    }
    __syncthreads();
#pragma unroll
    for (int i = 0; i < 4; ++i) { const int q = tid + 512 * i; *(u32x4*)(Sg + q * 8) = *(const LAS u32x4*)(lds + HL_GB + q * 16); }
    if (tid < 128) DEC[(size_t)unit * 128 + tid] = __builtin_amdgcn_exp2f(((const LAS float*)(lds + HL_RED))[tid]);
    __syncthreads();
}
__device__ __forceinline__ void hgrn_pass_c(LAS unsigned char* lds, int unit, bf16_t* HG, const float* LB, const bf16_t* S, const float* hgain, const bf16_t* Og, const float* lse) {
    const int tid = threadIdx.x, lane = tid & 63, wid = __builtin_amdgcn_readfirstlane(tid >> 6), r = lane & 31, h = lane >> 5;
    const int b = unit >> 10, hd = (unit >> 7) & 7, c = unit & 127;
    hgrn_setup<false>(lds, b, hd, c, HG, LB);
    const int vb = wid >> 1, tb = wid & 1;
    const bf16_t* Sg = S + (size_t)unit * 16384;
    f32x16 o;
#pragma unroll
    for (int i = 0; i < 16; ++i) o[i] = 0.f;
    const int trow = 32 * tb + r, vrow = 32 * vb + r;
    bf16x8 qf[8];
#pragma unroll
    for (int ks = 0; ks < 8; ++ks) qf[ks] = *(const LAS bf16x8*)(lds + HL_QT + trow * 256 + (((2 * ks + h) ^ (trow & 15)) << 4));
#pragma unroll
    for (int ks = 0; ks < 8; ++ks) { const bf16x8 af = __builtin_bit_cast(bf16x8, *(const u32x4*)(Sg + vrow * 128 + 16 * ks + 8 * h)); o = MFMA32(af, qf[ks], o); }
    for (int sb = 0; sb <= tb; ++sb) {
        f32x16 X;
#pragma unroll
        for (int i = 0; i < 16; ++i) X[i] = 0.f;
        const int srow = 32 * sb + r;
#pragma unroll
        for (int ks = 0; ks < 8; ++ks) { const bf16x8 af = *(const LAS bf16x8*)(lds + HL_KT + srow * 256 + (((2 * ks + h) ^ (srow & 15)) << 4)); X = MFMA32(af, qf[ks], X); }
        if (sb == tb) {
#pragma unroll
            for (int i = 0; i < 16; ++i) if (crow(i, h) > r) X[i] = 0.f;
        }
#pragma unroll
        for (int ss = 0; ss < 2; ++ss) {
            const bf16x8 pb = pack8(X, 8 * ss);
            const int c0 = 4 * sb + 2 * ss;
            const u32x2 lo = *(const LAS u32x2*)(lds + HL_VT + vrow * 128 + ((c0 ^ (vrow & 7)) << 4) + 8 * h);
            const u32x2 hi = *(const LAS u32x2*)(lds + HL_VT + vrow * 128 + (((c0 + 1) ^ (vrow & 7)) << 4) + 8 * h);
            u32x4 aw; aw.x = lo.x; aw.y = lo.y; aw.z = hi.x; aw.w = hi.y;
            o = MFMA32(__builtin_bit_cast(bf16x8, aw), pb, o);
        }
    }
    float ssq = 0.f;
#pragma unroll
    for (int i = 0; i < 16; ++i) ssq += o[i] * o[i];
    ssq += __shfl_xor(ssq, 32);
    LAS float* RED = (LAS float*)(lds + HL_RED);
    if (h == 0) RED[vb * 64 + trow] = ssq;
    __syncthreads();
    const float tot = (RED[trow] + RED[64 + trow]) + (RED[128 + trow] + RED[192 + trow]);
    const float rstd = rsqrtf(tot * (1.f / 128.f) + EPS);
#pragma unroll
    for (int gq = 0; gq < 4; ++gq) {
        u32x2 w; w.x = cvtpk(o[4 * gq] * rstd, o[4 * gq + 1] * rstd); w.y = cvtpk(o[4 * gq + 2] * rstd, o[4 * gq + 3] * rstd);
        *(LAS u32x2*)(lds + HL_STG + trow * 272 + (32 * vb + 8 * gq + 4 * h) * 2) = w;
    }
    __syncthreads();
    const size_t row0 = (size_t)b * SEQ + (size_t)c * 64;
#pragma unroll
    for (int i = 0; i < 2; ++i) {
        const int q = tid + 512 * i, t = q >> 4, cc = q & 15;
        const size_t row = row0 + t;
        bf16_t* rp = HG + row * 4096 + hd * 128 + cc * 8;
        const u32x4 ov = *(const LAS u32x4*)(lds + HL_STG + t * 272 + cc * 16);
        const u32x4 gw = *(const u32x4*)(rp + 3072);
        const f32x4 ga = *(const f32x4*)(hgain + hd * 128 + cc * 8), gb = *(const f32x4*)(hgain + hd * 128 + cc * 8 + 4);
        const float gn[8] = {ga[0], ga[1], ga[2], ga[3], gb[0], gb[1], gb[2], gb[3]};
        const unsigned ovs[4] = {ov.x, ov.y, ov.z, ov.w}, gws[4] = {gw.x, gw.y, gw.z, gw.w};
        float ro[8];
#pragma unroll
        for (int e = 0; e < 4; ++e) { ro[2 * e] = bflo(ovs[e]) * gn[2 * e] * siluf_(bflo(gws[e])); ro[2 * e + 1] = bfhi(ovs[e]) * gn[2 * e + 1] * siluf_(bfhi(gws[e])); }
        const float l0 = lse[((size_t)0 * MTOK + row) * 8 + hd], l1 = lse[((size_t)1 * MTOK + row) * 8 + hd], l2 = lse[((size_t)2 * MTOK + row) * 8 + hd];
        const float mx = fmaxf(l0, fmaxf(l1, l2));
        float w0 = __builtin_amdgcn_exp2f(l0 - mx), w1 = __builtin_amdgcn_exp2f(l1 - mx), w2 = __builtin_amdgcn_exp2f(l2 - mx);
        const float wi = 1.f / (w0 + w1 + w2); w0 *= wi; w1 *= wi; w2 *= wi;
        const bf16_t* op = Og + row * 3072 + hd * 128 + cc * 8;
        const u32x4 a0 = *(const u32x4*)(op), a1 = *(const u32x4*)(op + 1024), a2 = *(const u32x4*)(op + 2048);
        const unsigned a0s[4] = {a0.x, a0.y, a0.z, a0.w}, a1s[4] = {a1.x, a1.y, a1.z, a1.w}, a2s[4] = {a2.x, a2.y, a2.z, a2.w};
        u32x4 wr_, wa_;
        unsigned wrs[4], was[4];
#pragma unroll
        for (int e = 0; e < 4; ++e) {
            wrs[e] = cvtpk(ro[2 * e], ro[2 * e + 1]);
            was[e] = cvtpk(w0 * bflo(a0s[e]) + w1 * bflo(a1s[e]) + w2 * bflo(a2s[e]), w0 * bfhi(a0s[e]) + w1 * bfhi(a1s[e]) + w2 * bfhi(a2s[e]));
        }
        wr_.x = wrs[0]; wr_.y = wrs[1]; wr_.z = wrs[2]; wr_.w = wrs[3];
        wa_.x = was[0]; wa_.y = was[1]; wa_.z = was[2]; wa_.w = was[3];
        *(u32x4*)(rp) = wr_;
        *(u32x4*)(rp + 1024) = wa_;
    }
    __syncthreads();
}

__global__ void __launch_bounds__(NTHR, 2) fwd_megakernel(Args args) {
    extern __shared__ __attribute__((aligned(16))) unsigned char lds_raw[];
    cg::grid_group grid = cg::this_grid();
    LAS unsigned char* lds = (LAS unsigned char*)lds_raw;
    const int tid = threadIdx.x, lane = tid & 63, wave = __builtin_amdgcn_readfirstlane(tid >> 6);
    const int G = gridDim.x, bx = blockIdx.x;
    const int gw = bx * NWAVES + wave, ngw = G * NWAVES;
    unsigned char* ws = args.ws;
    if (args.out == nullptr) grid.sync();
    volatile LAS unsigned* bst = (volatile LAS unsigned*)(lds + 131072 + 64);
    if (tid < 2) bst[tid] = 0u;
    __syncthreads();
    const XcdBarrier gbar = xcd_barrier_post((unsigned*)(ws + WS_BAR), bst);
    const float* x = args.in[0]; const float* w_in = args.in[1]; const float* w_pa = args.in[2]; const float* w_pr = args.in[3]; const float* w_o = args.in[4];
    const float* lbraw = args.in[5]; const float* hgain = args.in[6]; const float* g_pre = args.in[7]; const float* g_post = args.in[8];
    const float* w_gu = args.in[9]; const float* w_dn = args.in[10]; const float* g_fpre = args.in[11]; const float* g_fpost = args.in[12];
    float* out = args.out;
    float* LB = (float*)(ws + WS_LB); float* LSE = (float*)(ws + WS_LSE); float* DEC = (float*)(ws + WS_DEC); float* ROPE = (float*)(ws + WS_ROPE);
    bf16_t* WIN_T = (bf16_t*)(ws + WS_WIN); bf16_t* XN = (bf16_t*)(ws + WS_XN); bf16_t* Qb = (bf16_t*)(ws + WS_Q); bf16_t* Kb = (bf16_t*)(ws + WS_K); bf16_t* Vb = (bf16_t*)(ws + WS_V);
    bf16_t* Sb = (bf16_t*)(ws + WS_S); bf16_t* HG = (bf16_t*)out;
    bf16_t* WPA_T = (bf16_t*)(ws + WS_WPA); bf16_t* WPR_T = (bf16_t*)(ws + WS_WPR); bf16_t* WO_T = (bf16_t*)(ws + WS_WO); bf16_t* WDN_T = (bf16_t*)(ws + WS_WDN);
    bf16_t* WGU_T = (bf16_t*)(ws + WS_WGU); bf16_t* Gt = (bf16_t*)(ws + WS_G); bf16_t* Yb = (bf16_t*)(ws + WS_Y); bf16_t* Z = (bf16_t*)(ws + WS_Z);
    bf16_t* A2 = (bf16_t*)(ws + WS_A2); bf16_t* FFH = (bf16_t*)(ws + WS_FFH); bf16_t* Z2 = (bf16_t*)(ws + WS_Z2);
    float* RSTD0 = (float*)(ws + WS_RSTD0); float* R2 = (float*)(ws + WS_R2);
    bf16_t* H1B = (bf16_t*)(ws + WS_Y);

    transpose_all<1>(w_in, DM, NIN, WIN_T, lds, gw, ngw, wave, lane);
    {
    f32x4 gpre[8];
#pragma unroll
    for (int j = 0; j < 8; ++j) gpre[j] = ((const f32x4*)g_pre)[128 * (j >> 1) + 2 * lane + (j & 1)];
    for (int row = gw; row < MTOK; row += ngw) {
        const f32x4* xr = (const f32x4*)(x + (size_t)row * DM) + 2 * lane;
        f32x4 v[8]; float s = 0.f;
#pragma unroll
        for (int j = 0; j < 8; ++j) { v[j] = xr[128 * (j >> 1) + (j & 1)]; s += (v[j][0] * v[j][0] + v[j][1] * v[j][1]) + (v[j][2] * v[j][2] + v[j][3] * v[j][3]); }
        const float rstd = rsqrtf(wave_sum(s) * (1.f / DM) + EPS);
        if (lane == 0) RSTD0[row] = rstd;
        u32x4* o16 = (u32x4*)(XN + (size_t)row * DM) + lane;
#pragma unroll
        for (int jj = 0; jj < 4; ++jj) { const f32x4 g0 = gpre[2 * jj], g1 = gpre[2 * jj + 1], p = v[2 * jj], q = v[2 * jj + 1]; u32x4 w;
            w.x = cvtpk(p[0] * rstd * g0[0], p[1] * rstd * g0[1]); w.y = cvtpk(p[2] * rstd * g0[2], p[3] * rstd * g0[3]);
            w.z = cvtpk(q[0] * rstd * g1[0], q[1] * rstd * g1[1]); w.w = cvtpk(q[2] * rstd * g1[2], q[3] * rstd * g1[3]); o16[64 * jj] = w; }
    }
    }
    if (bx == 0 && tid < 64) ROPE[tid] = args.inv_freq[tid];
    if (bx == 0) for (int j = tid; j < 1024; j += NTHR) LB[j] = 1.f / (1.f + __expf(lbraw[1024 + j] - lbraw[j]));
    xcd_barrier(gbar);

    {
        pg8::Gemm g{XN, WIN_T, MTOK, 13312, DM, DM, DM}; pg8::StaticOrder S; S.init(MTOK, 13312, G, bx);
        pg8::EpiProj E{Qb, Kb, Vb, HG, ROPE};
        pg8::gemm_phase<pg8::EpiProj, pg8::StaticOrder, true, true>(lds, g, S, E);
    }
    xcd_barrier(gbar);

    {
        const int vcu = ((G & 7) == 0) ? (bx & 7) * (G >> 3) + (bx >> 3) : bx;
        for (int a = vcu; a < 3072; a += G) attn_unit(lds, a, Qb, Kb, Vb, Qb, LSE);
    }
    for (int u = bx; u < 2048; u += G) hgrn_pass_a(lds, u, HG, LB, Sb, DEC);
    xcd_barrier(gbar);

    for (int idx = bx * NTHR + tid; idx < 16 * 8192; idx += G * NTHR) {
        const int bh = idx >> 13, e2 = idx & 8191;
        unsigned* sp = (unsigned*)(Sb + (size_t)bh * 128 * 16384) + e2;
        const float* dp = DEC + (size_t)bh * 128 * 128 + ((2 * e2) & 127);
        float c0 = 0.f, c1 = 0.f;
        for (int cb = 0; cb < 128; cb += 16) {
            unsigned wv[16]; float d0v[16], d1v[16];
#pragma unroll
            for (int c = 0; c < 16; ++c) { wv[c] = sp[(size_t)(cb + c) * 8192]; d0v[c] = dp[(cb + c) * 128]; d1v[c] = dp[(cb + c) * 128 + 1]; }
#pragma unroll
            for (int c = 0; c < 16; ++c) { const unsigned w = wv[c]; wv[c] = cvtpk(c0, c1); c0 = d0v[c] * c0 + bflo(w); c1 = d1v[c] * c1 + bfhi(w); }
#pragma unroll
            for (int c = 0; c < 16; ++c) sp[(size_t)(cb + c) * 8192] = wv[c];
        }
    }
    transpose_all<0>(w_pa, 1024, DM, WPA_T, lds, gw, ngw, wave, lane);
    transpose_all<0>(w_pr, 1024, DM, WPR_T, lds, gw, ngw, wave, lane);
    transpose_all<0>(w_o, DM, DM, WO_T, lds, gw, ngw, wave, lane);
    transpose_all<0>(w_dn, DFF, DM, WDN_T, lds, gw, ngw, wave, lane);
    transpose_all<2>(w_gu, DM, 2 * DFF, WGU_T, lds, gw, ngw, wave, lane, g_fpre);
    __syncthreads();
    {
        pg8::Gemm g{XN, (const bf16_t*)(ws + WS_WING), MTOK, 4096, DM, DM, DM}; pg8::StaticOrder S; S.init(MTOK, 4096, G, bx);
        pg8::EpiPlain E{Gt, 4096};
        pg8::gemm_phase<pg8::EpiPlain, pg8::StaticOrder, true, true>(lds, g, S, E);
    }
    xcd_barrier(gbar);

    for (int u = bx; u < 2048; u += G) hgrn_pass_c(lds, u, HG, LB, Sb, hgain, Qb, LSE);
    xcd_barrier(gbar);

    {
        pg8::PairOrder S; S.init(MTOK, DM, G, bx); S.A20 = HG + 1024; S.A21 = HG; S.B20 = WPA_T; S.B21 = WPR_T;
        pg8::Gemm g{HG, WPA_T, MTOK, DM, 1024, 4096, 1024};
        pg8::EpiGate2 E{Yb, Gt};
        pg8::gemm_phase<pg8::EpiGate2, pg8::PairOrder, true, true>(lds, g, S, E);
    }
    xcd_barrier(gbar);

    {
        pg8::Gemm g{Yb, WO_T, MTOK, DM, DM, DM, DM}; pg8::StaticOrder S; S.init(MTOK, DM, G, bx);
        pg8::EpiPlain E{Z, DM};
        pg8::gemm_phase<pg8::EpiPlain, pg8::StaticOrder, true, true>(lds, g, S, E);
    }
    xcd_barrier(gbar);

    {
    int lane = threadIdx.x & 63; asm volatile("" : "+v"(lane));
    int gw = bx * NWAVES + __builtin_amdgcn_readfirstlane(threadIdx.x >> 6); asm volatile("" : "+s"(gw));
    f32x4 gpo[8], igp[8];
#pragma unroll
    for (int j = 0; j < 8; ++j) { const int gi = 128 * (j >> 1) + 2 * lane + (j & 1); gpo[j] = ((const f32x4*)g_post)[gi];
        const f32x4 gq = ((const f32x4*)g_pre)[gi]; igp[j] = (f32x4){1.f / gq[0], 1.f / gq[1], 1.f / gq[2], 1.f / gq[3]}; }
    for (int row = gw; row < MTOK; row += ngw) {
        const u32x4* zr = (const u32x4*)(Z + (size_t)row * DM) + lane; const u32x4* xr = (const u32x4*)(XN + (size_t)row * DM) + lane;
        const float ir0 = 1.f / RSTD0[row];
        u32x4 zq[4], xq[4];
#pragma unroll
        for (int jj = 0; jj < 4; ++jj) { zq[jj] = zr[64 * jj]; xq[jj] = xr[64 * jj]; }
        f32x4 v[8], xv8[8]; float s = 0.f;
#pragma unroll
        for (int j = 0; j < 8; ++j) { const unsigned z0 = (j & 1) ? zq[j >> 1].z : zq[j >> 1].x, z1 = (j & 1) ? zq[j >> 1].w : zq[j >> 1].y;
            const unsigned x0 = (j & 1) ? xq[j >> 1].z : xq[j >> 1].x, x1 = (j & 1) ? xq[j >> 1].w : xq[j >> 1].y;
            v[j] = (f32x4){bflo(z0), bfhi(z0), bflo(z1), bfhi(z1)};
            xv8[j] = (f32x4){bflo(x0) * ir0 * igp[j][0], bfhi(x0) * ir0 * igp[j][1], bflo(x1) * ir0 * igp[j][2], bfhi(x1) * ir0 * igp[j][3]};
            s += (v[j][0] * v[j][0] + v[j][1] * v[j][1]) + (v[j][2] * v[j][2] + v[j][3] * v[j][3]); }
        const float r1 = rsqrtf(wave_sum(s) * (1.f / DM) + EPS);
        float s2 = 0.f;
#pragma unroll
        for (int j = 0; j < 8; ++j) { const f32x4 gg = gpo[j]; const f32x4 xv = xv8[j]; f32x4 hv;
            hv[0] = xv[0] + v[j][0] * r1 * gg[0]; hv[1] = xv[1] + v[j][1] * r1 * gg[1]; hv[2] = xv[2] + v[j][2] * r1 * gg[2]; hv[3] = xv[3] + v[j][3] * r1 * gg[3];
            v[j] = hv; s2 += (hv[0] * hv[0] + hv[1] * hv[1]) + (hv[2] * hv[2] + hv[3] * hv[3]); }
        const float r2 = rsqrtf(wave_sum(s2) * (1.f / DM) + EPS);
        if (lane == 0) R2[row] = r2;
        u32x4* h16 = (u32x4*)(H1B + (size_t)row * DM) + lane;
#pragma unroll
        for (int jj = 0; jj < 4; ++jj) { const f32x4 p = v[2 * jj], q = v[2 * jj + 1]; u32x4 hw;
            hw.x = cvtpk(p[0], p[1]); hw.y = cvtpk(p[2], p[3]); hw.z = cvtpk(q[0], q[1]); hw.w = cvtpk(q[2], q[3]); h16[64 * jj] = hw; }
    }
    }
    xcd_barrier(gbar);

    {
        pg8::Gemm g{H1B, WGU_T, MTOK, 2 * DFF, DM, DM, DM}; pg8::StaticOrder S; S.init(MTOK, 2 * DFF, G, bx);
        pg8::EpiSwiGLU E{FFH, DFF, R2};
        pg8::gemm_phase<pg8::EpiSwiGLU, pg8::StaticOrder, true, true>(lds, g, S, E);
    }
    xcd_barrier(gbar);

    {
        pg8::Gemm g{FFH, WDN_T, MTOK, DM, DFF, DFF, DFF}; pg8::StaticOrder S; S.init(MTOK, DM, G, bx);
        pg8::EpiPlain E{Z2, DM};
        pg8::gemm_phase<pg8::EpiPlain, pg8::StaticOrder, true, true>(lds, g, S, E);
    }
    xcd_barrier(gbar);

    {
    int lane = threadIdx.x & 63; asm volatile("" : "+v"(lane));
    int gw = bx * NWAVES + __builtin_amdgcn_readfirstlane(threadIdx.x >> 6); asm volatile("" : "+s"(gw));
    f32x4 gfo[8];
#pragma unroll
    for (int j = 0; j < 8; ++j) gfo[j] = ((const f32x4*)g_fpost)[128 * (j >> 1) + 2 * lane + (j & 1)];
    for (int row = gw; row < MTOK; row += ngw) {
        const u32x4* zr = (const u32x4*)(Z2 + (size_t)row * DM) + lane; const u32x4* hr = (const u32x4*)(H1B + (size_t)row * DM) + lane;
        f32x4* orow = (f32x4*)(out + (size_t)row * DM) + 2 * lane;
        u32x4 zq[4], hq[4];
#pragma unroll
        for (int jj = 0; jj < 4; ++jj) { zq[jj] = zr[64 * jj]; hq[jj] = hr[64 * jj]; }
        f32x4 v[8]; float s = 0.f;
#pragma unroll
        for (int j = 0; j < 8; ++j) { const unsigned z0 = (j & 1) ? zq[j >> 1].z : zq[j >> 1].x, z1 = (j & 1) ? zq[j >> 1].w : zq[j >> 1].y;
            v[j] = (f32x4){bflo(z0), bfhi(z0), bflo(z1), bfhi(z1)}; s += (v[j][0] * v[j][0] + v[j][1] * v[j][1]) + (v[j][2] * v[j][2] + v[j][3] * v[j][3]); }
        const float r1 = rsqrtf(wave_sum(s) * (1.f / DM) + EPS);
#pragma unroll
        for (int j = 0; j < 8; ++j) { const f32x4 gg = gfo[j]; const unsigned h0 = (j & 1) ? hq[j >> 1].z : hq[j >> 1].x, h1_ = (j & 1) ? hq[j >> 1].w : hq[j >> 1].y;
            f32x4 hv = (f32x4){bflo(h0), bfhi(h0), bflo(h1_), bfhi(h1_)};
            hv[0] += v[j][0] * r1 * gg[0]; hv[1] += v[j][1] * r1 * gg[1]; hv[2] += v[j][2] * r1 * gg[2]; hv[3] += v[j][3] * r1 * gg[3]; __builtin_nontemporal_store(hv, &orow[128 * (j >> 1) + (j & 1)]); }
    }
    }
}

extern "C" void kernel_launch(void* const* d_in, const int* in_sizes, int n_in, void* d_out, int out_size, void* d_ws, size_t ws_size, hipStream_t stream) {
    static int grid = 0;
    if (grid == 0) {
        if (n_in != 13 || out_size != MTOK * DM || ws_size < WS_END) { fprintf(stderr, "kernel_launch: unexpected shapes (n_in %d out %d ws %zu)\n", n_in, out_size, ws_size); grid = -1; return; }
        int dev = 0, cus = 0, per_cu = 0;
        hipGetDevice(&dev); hipDeviceGetAttribute(&cus, hipDeviceAttributeMultiprocessorCount, dev);
        hipFuncSetAttribute((const void*)fwd_megakernel, hipFuncAttributeMaxDynamicSharedMemorySize, LDS_BYTES);
        hipOccupancyMaxActiveBlocksPerMultiprocessor(&per_cu, (const void*)fwd_megakernel, NTHR, LDS_BYTES);
        if (per_cu < 1) per_cu = 1;
        (void)hipGetLastError();
        grid = cus;
    }
    if (grid < 0) return;
    Args a{};
    for (int i = 0; i < 13; ++i) a.in[i] = (const float*)d_in[i];
    a.out = (float*)d_out; a.ws = (unsigned char*)d_ws;
    for (int i = 0; i < 64; ++i) a.inv_freq[i] = (float)pow(10000.0, -(double)(2 * i) / 128.0);
    (void)hipMemsetAsync((unsigned char*)d_ws + WS_BAR, 0, WS_BAR_BYTES, stream);
    void* kargs[] = {&a};
    hipError_t e = hipLaunchCooperativeKernel((const void*)fwd_megakernel, dim3(grid), dim3(NTHR), kargs, LDS_BYTES, stream);
    if (e != hipSuccess) fprintf(stderr, "cooperative launch failed: %s (grid %d)\n", hipGetErrorString(e), grid);
}
```

```cpp
#include <hip/hip_runtime.h>
#include <hip/hip_cooperative_groups.h>
#include <cstdio>
#include <cstdint>
#include <cmath>
namespace cg = cooperative_groups;

namespace pg8 {
#define PG8_LAS __attribute__((address_space(3)))
typedef unsigned short bf16_t;
typedef short bf16x8 __attribute__((ext_vector_type(8)));
typedef float f32x4 __attribute__((ext_vector_type(4)));
typedef unsigned u32x4 __attribute__((ext_vector_type(4)));
typedef unsigned u32x2 __attribute__((ext_vector_type(2)));
constexpr int BM = 256, BK = 64, HALF = 128, HTB = HALF * BK * 2, STAGE_BYTES = 8 * HTB, NXCD = 8, WGM = 4;

__host__ __device__ __forceinline__ int lds_byte(int r, int c) { const int st = (r >> 4) * 2 + (c >> 5), rr = r & 15, cc = c & 31, ob = rr * 64 + cc * 2; return st * 1024 + (ob ^ (((ob >> 9) & 1) << 5)); }
__host__ __device__ __forceinline__ void stage_rc(int b, int& R, int& C) { const int st = b / 1024, sb = b % 1024, swz = sb ^ (((sb >> 9) & 1) << 5); R = (st >> 1) * 16 + swz / 64; C = (st & 1) * 32 + (swz % 64) / 2; }
__host__ __device__ __forceinline__ int perm32(int rho) { const int n = rho >> 4, i = rho & 15; return 8 * (i >> 2) + 4 * n + (i & 3); }

struct Unit { int pm, pn, half; };
struct Gemm { const bf16_t* A; const bf16_t* Bt; int M, N, K, lda, ldb; };

struct StaticOrder {
    int nM, nN, nwg, G, c;
    __host__ __device__ void init(int M, int N, int G_, int c_) { nM = M / BM; nN = N / BM; nwg = nM * nN; G = G_; c = c_; }
    __host__ __device__ bool next(int i, Unit& u) const {
        const long L = (long)i * G + c; if (L >= nwg) return false;
        int wgid = (int)L; const int xcd_ = wgid % NXCD; { const int q = nwg / NXCD, r = nwg % NXCD, xcd = wgid % NXCD, off = wgid / NXCD; wgid = (xcd < r ? xcd * (q + 1) : r * (q + 1) + (xcd - r) * q) + off; }
        const int nig = WGM * nN, gid = wgid / nig, fm = gid * WGM, gsz = (nM - fm) < WGM ? (nM - fm) : WGM;
        u.pm = fm + ((wgid % nig) % gsz); u.pn = ((wgid % nig) / gsz + xcd_ * (nN / NXCD)) % nN; u.half = 0; return true;
    }
    __device__ __forceinline__ const char* baseA(const Gemm& g, const Unit&) const { return (const char*)g.A; }
    __device__ __forceinline__ const char* baseB(const Gemm& g, const Unit&) const { return (const char*)g.Bt; }
    __device__ __forceinline__ void a_ready(const Unit&) const {}
    __device__ __forceinline__ void done(const Unit&) const {}
};
struct PairOrder : StaticOrder {
    const bf16_t *A20, *A21, *B20, *B21;
    __device__ bool next(int i, Unit& u) const { const bool r = StaticOrder::next(i >> 1, u); u.half = i & 1; return r; }
    __device__ __forceinline__ const char* baseA(const Gemm&, const Unit& u) const { return (const char*)(u.half ? A21 : A20); }
    __device__ __forceinline__ const char* baseB(const Gemm&, const Unit& u) const { return (const char*)(u.half ? B21 : B20); }
};

typedef float f32x2_t __attribute__((ext_vector_type(2))); typedef __bf16 bf16x2_t __attribute__((ext_vector_type(2)));
__device__ __forceinline__ unsigned cvtpk(float lo, float hi) { f32x2_t v = {lo, hi}; bf16x2_t b = __builtin_convertvector(v, bf16x2_t); return __builtin_bit_cast(unsigned, b); }
__device__ __forceinline__ float bflo(unsigned w) { return __uint_as_float(w << 16); }
__device__ __forceinline__ float bfhi(unsigned w) { return __uint_as_float(w & 0xffff0000u); }
__device__ __forceinline__ float sigmoidf_(float x) { return __builtin_amdgcn_rcpf(1.f + __builtin_amdgcn_exp2f(-1.4426950408889634f * x)); }
__device__ __forceinline__ float siluf_(float x) { return x * sigmoidf_(x); }


constexpr float QSCALE = 0.08838834764831845f * 1.4426950408889634f;

struct EpiProj {
    static constexpr bool PERM = true, AFTER_DRAIN = false, TWO_STAGE = false;
    bf16_t *Q, *Kb, *V, *HG; const float* invf;
    __device__ __forceinline__ void operator()(const f32x4 (&acc)[2][2][4][2], const Unit& u, int wr, int wc, int fr, int fq) const {
        const int row0 = u.pm * BM + wr * 64 + fr;
        if (u.pn < 24) {
            const bool isq = u.pn < 12; bf16_t* base = isq ? Q : Kb; const int pnl = isq ? u.pn : u.pn - 12; const float sc = isq ? QSCALE : 1.f;
            const int head = 2 * pnl + (wc >> 1), d0 = 32 * (wc & 1) + 8 * fq;
            const f32x4 fa = *(const f32x4*)(invf + d0), fb = *(const f32x4*)(invf + d0 + 4);
            const float fe[8] = {fa[0], fa[1], fa[2], fa[3], fb[0], fb[1], fb[2], fb[3]};
#pragma unroll
            for (int ai = 0; ai < 2; ++ai)
#pragma unroll
                for (int m = 0; m < 4; ++m) {
                    const int row = row0 + ai * HALF + m * 16, pos = row & 8191;
                    const float posf = (float)pos;
                    const f32x4 l0 = acc[ai][0][m][0], l1 = acc[ai][0][m][1], h0 = acc[ai][1][m][0], h1 = acc[ai][1][m][1];
                    float lo[8] = {l0[0], l0[1], l0[2], l0[3], l1[0], l1[1], l1[2], l1[3]};
                    float hi[8] = {h0[0], h0[1], h0[2], h0[3], h1[0], h1[1], h1[2], h1[3]};
                    float cs[8], sn[8];
#pragma unroll
                    for (int e = 0; e < 8; ++e) {
                        const float ang = posf * fe[e];
                        const float kq = __builtin_rintf(ang * 0.15915494309189535f);
                        float rr = __builtin_fmaf(-kq, 6.28125f, ang); rr = __builtin_fmaf(-kq, 1.9353071795864769e-3f, rr);
                        const float tt = rr * 0.15915494309189535f;
                        cs[e] = __builtin_amdgcn_cosf(tt); sn[e] = __builtin_amdgcn_sinf(tt);
                    }
                    float ol[8], oh[8];
#pragma unroll
                    for (int e = 0; e < 8; ++e) { ol[e] = (lo[e] * cs[e] - hi[e] * sn[e]) * sc; oh[e] = (hi[e] * cs[e] + lo[e] * sn[e]) * sc; }
                    bf16_t* rowp = base + (size_t)row * 3072 + head * 128 + d0;
                    u32x4 w; w.x = cvtpk(ol[0], ol[1]); w.y = cvtpk(ol[2], ol[3]); w.z = cvtpk(ol[4], ol[5]); w.w = cvtpk(ol[6], ol[7]);
                    *(u32x4*)rowp = w;
                    w.x = cvtpk(oh[0], oh[1]); w.y = cvtpk(oh[2], oh[3]); w.z = cvtpk(oh[4], oh[5]); w.w = cvtpk(oh[6], oh[7]);
                    *(u32x4*)(rowp + 64) = w;
                }
        } else {
            bf16_t* base; int ldc, colt;
            if (u.pn < 36) { base = V; ldc = 3072; colt = (u.pn - 24) * BM; } else { base = HG; ldc = 4096; colt = (u.pn - 36) * BM; }
            const int col0 = colt + wc * 32 + 8 * fq;
#pragma unroll
            for (int ai = 0; ai < 2; ++ai)
#pragma unroll
                for (int m = 0; m < 4; ++m) { bf16_t* rowp = base + (size_t)(row0 + ai * HALF + m * 16) * ldc + col0;
#pragma unroll
                    for (int bj = 0; bj < 2; ++bj) { const f32x4 v0 = acc[ai][bj][m][0], v1 = acc[ai][bj][m][1];
                        u32x4 w; w.x = cvtpk(v0[0], v0[1]); w.y = cvtpk(v0[2], v0[3]); w.z = cvtpk(v1[0], v1[1]); w.w = cvtpk(v1[2], v1[3]);
                        *(u32x4*)(rowp + bj * HALF) = w; } }
        }
    }
};
struct EpiPlain {
    static constexpr bool PERM = true, AFTER_DRAIN = false, TWO_STAGE = false;
    bf16_t* O; int ldc;
    __device__ __forceinline__ void operator()(const f32x4 (&acc)[2][2][4][2], const Unit& u, int wr, int wc, int fr, int fq) const {
        const int row0 = u.pm * BM + wr * 64 + fr, col0 = u.pn * BM + wc * 32 + 8 * fq;
#pragma unroll
        for (int ai = 0; ai < 2; ++ai)
#pragma unroll
            for (int m = 0; m < 4; ++m) { bf16_t* rowp = O + (size_t)(row0 + ai * HALF + m * 16) * ldc + col0;
#pragma unroll
                for (int bj = 0; bj < 2; ++bj) { const f32x4 v0 = acc[ai][bj][m][0], v1 = acc[ai][bj][m][1];
                    u32x4 w; w.x = cvtpk(v0[0], v0[1]); w.y = cvtpk(v0[2], v0[3]); w.z = cvtpk(v1[0], v1[1]); w.w = cvtpk(v1[2], v1[3]);
                    *(u32x4*)(rowp + bj * HALF) = w; } }
    }
};
template <bool ACCUM> struct EpiGate {
    static constexpr bool PERM = true, AFTER_DRAIN = false, TWO_STAGE = false;
    bf16_t* Y; const bf16_t* G; int goff;
    __device__ __forceinline__ void operator()(const f32x4 (&acc)[2][2][4][2], const Unit& u, int wr, int wc, int fr, int fq) const {
        const int row0 = u.pm * BM + wr * 64 + fr, col0 = u.pn * BM + wc * 32 + 8 * fq;
#pragma unroll
        for (int ai = 0; ai < 2; ++ai) {
            u32x4 gwv[4][2], ywv[4][2];
#pragma unroll
            for (int m = 0; m < 4; ++m)
#pragma unroll
                for (int bj = 0; bj < 2; ++bj) { const size_t row = (size_t)(row0 + ai * HALF + m * 16);
                    gwv[m][bj] = *(const u32x4*)(G + row * 4096 + goff + col0 + bj * HALF);
                    if (ACCUM) ywv[m][bj] = *(const u32x4*)(Y + row * 2048 + col0 + bj * HALF); }
#pragma unroll
            for (int m = 0; m < 4; ++m) { const size_t row = (size_t)(row0 + ai * HALF + m * 16);
#pragma unroll
                for (int bj = 0; bj < 2; ++bj) {
                    const u32x4 gw = gwv[m][bj];
                    bf16_t* yp = Y + row * 2048 + col0 + bj * HALF;
                    const f32x4 v0 = acc[ai][bj][m][0], v1 = acc[ai][bj][m][1];
                    float o[8] = {v0[0], v0[1], v0[2], v0[3], v1[0], v1[1], v1[2], v1[3]};
                    const unsigned gws[4] = {gw.x, gw.y, gw.z, gw.w};
#pragma unroll
                    for (int e = 0; e < 4; ++e) { o[2 * e] *= sigmoidf_(bflo(gws[e])); o[2 * e + 1] *= sigmoidf_(bfhi(gws[e])); }
                    if (ACCUM) { const u32x4 yw = ywv[m][bj]; const unsigned yws[4] = {yw.x, yw.y, yw.z, yw.w};
#pragma unroll
                        for (int e = 0; e < 4; ++e) { o[2 * e] += bflo(yws[e]); o[2 * e + 1] += bfhi(yws[e]); } }
                    u32x4 w; w.x = cvtpk(o[0], o[1]); w.y = cvtpk(o[2], o[3]); w.z = cvtpk(o[4], o[5]); w.w = cvtpk(o[6], o[7]);
                    *(u32x4*)yp = w; } }
        }
    }
};
struct EpiGate2 {
    static constexpr bool PERM = true, AFTER_DRAIN = false, TWO_STAGE = true;
    bf16_t* Y; const bf16_t* G;
    __device__ __forceinline__ void mid(f32x4 (&acc)[2][2][4][2], const Unit& u, int wr, int wc, int fr, int fq) const {
        const int row0 = u.pm * BM + wr * 64 + fr, col0 = u.pn * BM + wc * 32 + 8 * fq;
#pragma unroll
        for (int ai = 0; ai < 2; ++ai) {
            u32x4 gav[4][2], grv[4][2];
#pragma unroll
            for (int m = 0; m < 4; ++m)
#pragma unroll
                for (int bj = 0; bj < 2; ++bj) { const bf16_t* gp = G + (size_t)(row0 + ai * HALF + m * 16) * 4096 + col0 + bj * HALF;
                    gav[m][bj] = *(const u32x4*)gp; grv[m][bj] = *(const u32x4*)(gp + 2048); }
#pragma unroll
            for (int m = 0; m < 4; ++m)
#pragma unroll
                for (int bj = 0; bj < 2; ++bj) {
                    const unsigned gas[4] = {gav[m][bj].x, gav[m][bj].y, gav[m][bj].z, gav[m][bj].w}, grs[4] = {grv[m][bj].x, grv[m][bj].y, grv[m][bj].z, grv[m][bj].w};
#pragma unroll
                    for (int e = 0; e < 4; ++e) {
                        const float ea0 = __builtin_amdgcn_exp2f(-1.4426950408889634f * bflo(gas[e])), ea1 = __builtin_amdgcn_exp2f(-1.4426950408889634f * bfhi(gas[e]));
                        const float er0 = __builtin_amdgcn_exp2f(-1.4426950408889634f * bflo(grs[e])), er1 = __builtin_amdgcn_exp2f(-1.4426950408889634f * bfhi(grs[e]));
                        const float r0 = (1.f + er0) * __builtin_amdgcn_rcpf(1.f + ea0), r1 = (1.f + er1) * __builtin_amdgcn_rcpf(1.f + ea1);
                        acc[ai][bj][m][e >> 1][(2 * e) & 3] *= r0; acc[ai][bj][m][e >> 1][(2 * e + 1) & 3] *= r1;
                    }
                }
        }
    }
    __device__ __forceinline__ void operator()(const f32x4 (&acc)[2][2][4][2], const Unit& u, int wr, int wc, int fr, int fq) const {
        const int row0 = u.pm * BM + wr * 64 + fr, col0 = u.pn * BM + wc * 32 + 8 * fq;
#pragma unroll
        for (int ai = 0; ai < 2; ++ai) {
            u32x4 grv[4][2];
#pragma unroll
            for (int m = 0; m < 4; ++m)
#pragma unroll
                for (int bj = 0; bj < 2; ++bj) grv[m][bj] = *(const u32x4*)(G + (size_t)(row0 + ai * HALF + m * 16) * 4096 + 2048 + col0 + bj * HALF);
#pragma unroll
            for (int m = 0; m < 4; ++m)
#pragma unroll
                for (int bj = 0; bj < 2; ++bj) {
                    const f32x4 v0 = acc[ai][bj][m][0], v1 = acc[ai][bj][m][1];
                    float o[8] = {v0[0], v0[1], v0[2], v0[3], v1[0], v1[1], v1[2], v1[3]};
                    const unsigned grs[4] = {grv[m][bj].x, grv[m][bj].y, grv[m][bj].z, grv[m][bj].w};
#pragma unroll
                    for (int e = 0; e < 4; ++e) { o[2 * e] *= sigmoidf_(bflo(grs[e])); o[2 * e + 1] *= sigmoidf_(bfhi(grs[e])); }
                    u32x4 w; w.x = cvtpk(o[0], o[1]); w.y = cvtpk(o[2], o[3]); w.z = cvtpk(o[4], o[5]); w.w = cvtpk(o[6], o[7]);
                    *(u32x4*)(Y + (size_t)(row0 + ai * HALF + m * 16) * 2048 + col0 + bj * HALF) = w;
                }
        }
    }
};
struct EpiF32 {
    static constexpr bool PERM = false, AFTER_DRAIN = false, TWO_STAGE = false;
    float* O; int ldc;
    __device__ __forceinline__ void operator()(const f32x4 (&acc)[2][2][4][2], const Unit& u, int wr, int wc, int fr, int fq) const {
        const int row0 = u.pm * BM + wr * 64 + fr, col0 = u.pn * BM + wc * 32 + 4 * fq;
#pragma unroll
        for (int ai = 0; ai < 2; ++ai)
#pragma unroll
            for (int m = 0; m < 4; ++m) { float* rowp = O + (size_t)(row0 + ai * HALF + m * 16) * ldc + col0;
#pragma unroll
                for (int bj = 0; bj < 2; ++bj)
#pragma unroll
                    for (int n = 0; n < 2; ++n) *(f32x4*)(rowp + bj * HALF + n * 16) = acc[ai][bj][m][n]; }
    }
};
struct EpiSwiGLU {
    static constexpr bool PERM = true, AFTER_DRAIN = false, TWO_STAGE = false;
    bf16_t* O; int ldc; const float* rs;
    __device__ __forceinline__ void operator()(const f32x4 (&acc)[2][2][4][2], const Unit& u, int wr, int wc, int fr, int fq) const {
        const int row0 = u.pm * BM + wr * 64 + fr, col0 = u.pn * HALF + wc * 32 + 8 * fq;
        float rr[2][4];
#pragma unroll
        for (int ai = 0; ai < 2; ++ai)
#pragma unroll
            for (int m = 0; m < 4; ++m) rr[ai][m] = rs[row0 + ai * HALF + m * 16];
#pragma unroll
        for (int ai = 0; ai < 2; ++ai)
#pragma unroll
            for (int m = 0; m < 4; ++m) { bf16_t* rowp = O + (size_t)(row0 + ai * HALF + m * 16) * ldc + col0; const float r_ = rr[ai][m];
                const f32x4 g0 = acc[ai][0][m][0] * r_, g1 = acc[ai][0][m][1] * r_, u0 = acc[ai][1][m][0] * r_, u1 = acc[ai][1][m][1] * r_;
                float o[8];
#pragma unroll
                for (int e = 0; e < 4; ++e) { o[e] = siluf_(g0[e]) * u0[e]; o[4 + e] = siluf_(g1[e]) * u1[e]; }
                u32x4 w; w.x = cvtpk(o[0], o[1]); w.y = cvtpk(o[2], o[3]); w.z = cvtpk(o[4], o[5]); w.w = cvtpk(o[6], o[7]);
                *(u32x4*)rowp = w; }
    }
};

template <class Epi, class Sched, bool ALIGN_EPI = false, bool SP2 = false>
__device__ __forceinline__ void gemm_phase(PG8_LAS unsigned char* lds, const Gemm g, const Sched& S, const Epi& E) {
    int tid_ = threadIdx.x; asm volatile("" : "+v"(tid_));
    const int tid = tid_, wid = __builtin_amdgcn_readfirstlane(tid >> 6), lane = tid & 63, wr = wid >> 2, wc = wid & 3, fr = lane & 15, fq = lane >> 4;
    const int K = g.K, nt = K / BK;
    unsigned voffA[2], voffB[2];
#pragma unroll
    for (int i = 0; i < 2; ++i) { int R, C; stage_rc(tid * 16 + i * 8192, R, C); const int Rb = Epi::PERM ? ((R & ~31) + perm32(R & 31)) : R;
        voffA[i] = (unsigned)(R * g.lda + C) * 2u; voffB[i] = (unsigned)(Rb * g.ldb + C) * 2u; }
    const size_t kstep = (size_t)(BK * 2);
    const size_t hstepA = (size_t)HALF * g.lda * 2, hstepB = (size_t)HALF * g.ldb * 2;
    const size_t tstepA = 2 * hstepA, tstepB = 2 * hstepB;
    const unsigned ldsw = (unsigned)wid * 1024u;
    const int aoff = lds_byte(wr * 64 + fr, fq * 8), boff = lds_byte(wc * 32 + fr, fq * 8);
#define PG8_SA(b, h) (((b) * 2 + (h)) * HTB)
#define PG8_SB(b, h) ((4 + (b) * 2 + (h)) * HTB)
#define PG8_STAGE(bufoff, gbase, voff) do { _Pragma("unroll") for (int _i = 0; _i < 2; ++_i) \
        __builtin_amdgcn_global_load_lds((const unsigned*)((const char*)(gbase) + (voff)[_i]), (PG8_LAS unsigned*)(lds + (bufoff) + ldsw + _i * 8192), 16, 0, 0); } while (0)
#define PG8_LDA(dst, b, h) do { _Pragma("unroll") for (int m = 0; m < 4; ++m) _Pragma("unroll") for (int k = 0; k < 2; ++k) dst[m][k] = *(const PG8_LAS bf16x8*)(lds + PG8_SA(b, h) + aoff + m * 2048 + k * 1024); } while (0)
#define PG8_LDB(dst, b, h) do { _Pragma("unroll") for (int n = 0; n < 2; ++n) _Pragma("unroll") for (int k = 0; k < 2; ++k) dst[n][k] = *(const PG8_LAS bf16x8*)(lds + PG8_SB(b, h) + boff + n * 2048 + k * 1024); } while (0)
#define PG8_MMA(ai, bj, At, Bt) do { __builtin_amdgcn_s_setprio(1); _Pragma("unroll") for (int m = 0; m < 4; ++m) _Pragma("unroll") for (int n = 0; n < 2; ++n) _Pragma("unroll") for (int k = 0; k < 2; ++k) \
        acc[ai][bj][m][n] = __builtin_amdgcn_mfma_f32_16x16x32_bf16(Bt[n][k], At[m][k], acc[ai][bj][m][n], 0, 0, 0); __builtin_amdgcn_s_setprio(0); } while (0)
#define PG8_WAIT_V(n) asm volatile("s_waitcnt vmcnt(" #n ")" ::: "memory")
#define PG8_WAIT_L(n) asm volatile("s_waitcnt lgkmcnt(" #n ")" ::: "memory")
#define PG8_BAR __builtin_amdgcn_s_barrier()
#define PG8_SCHED __builtin_amdgcn_sched_barrier(0)
    Unit cur, nxt; int ui = 0;
    if (!S.next(0, cur)) return;
    f32x4 acc[2][2][4][2];
#pragma unroll
    for (int a = 0; a < 2; ++a)
#pragma unroll
        for (int b = 0; b < 2; ++b)
#pragma unroll
            for (int m = 0; m < 4; ++m)
#pragma unroll
                for (int n = 0; n < 2; ++n) acc[a][b][m][n] = (f32x4){0.f, 0.f, 0.f, 0.f};
    bf16x8 At[4][2], B0[2][2], B1[2][2];
    const char* cA = S.baseA(g, cur) + (size_t)cur.pm * tstepA; const char* cB = S.baseB(g, cur) + (size_t)cur.pn * tstepB;
    S.a_ready(cur);
    if constexpr (SP2) {
        PG8_STAGE(PG8_SB(0, 0), cB, voffB); PG8_STAGE(PG8_SB(0, 1), cB + hstepB, voffB); PG8_STAGE(PG8_SA(0, 0), cA, voffA); PG8_STAGE(PG8_SA(0, 1), cA + hstepA, voffA);
        if (wr == 1) PG8_BAR;
        PG8_WAIT_V(2); PG8_BAR;
        PG8_STAGE(PG8_SB(1, 0), cB + kstep, voffB); PG8_STAGE(PG8_SA(1, 0), cA + kstep, voffA); PG8_STAGE(PG8_SB(1, 1), cB + hstepB + kstep, voffB);
        PG8_WAIT_V(6); PG8_BAR;
    } else {
        PG8_STAGE(PG8_SB(0, 0), cB, voffB); PG8_STAGE(PG8_SA(0, 0), cA, voffA); PG8_STAGE(PG8_SB(0, 1), cB + hstepB, voffB); PG8_STAGE(PG8_SA(0, 1), cA + hstepA, voffA);
        if (wr == 1) PG8_BAR;
        PG8_WAIT_V(4); PG8_BAR;
        PG8_STAGE(PG8_SB(1, 0), cB + kstep, voffB); PG8_STAGE(PG8_SA(1, 0), cA + kstep, voffA); PG8_STAGE(PG8_SB(1, 1), cB + hstepB + kstep, voffB);
        PG8_WAIT_V(6); PG8_BAR;
    }
    for (;;) {
        const bool has_next = S.next(ui + 1, nxt);
        const char* nA = has_next ? S.baseA(g, nxt) + (size_t)nxt.pm * tstepA : cA; const char* nB = has_next ? S.baseB(g, nxt) + (size_t)nxt.pn * tstepB : cB;
        for (int t = 0; t < nt; t += 2) {
            const bool last = (t == nt - 2);
            const char* a1 = cA + (size_t)(t + 1) * kstep;
            const char* a2 = last ? nA : cA + (size_t)(t + 2) * kstep; const char* b2 = last ? nB : cB + (size_t)(t + 2) * kstep;
            const char* a3 = a2 + kstep; const char* b3 = b2 + kstep;
            if (last && has_next) S.a_ready(nxt);
            if constexpr (SP2) {
            PG8_LDB(B0, 0, 0); PG8_LDB(B1, 0, 1); PG8_SCHED; PG8_LDA(At, 0, 0); PG8_STAGE(PG8_SA(1, 1), a1 + hstepA, voffA);
            PG8_WAIT_V(8); PG8_WAIT_L(0); PG8_BAR; PG8_MMA(0, 0, At, B0); PG8_MMA(0, 1, At, B1); PG8_BAR; PG8_SCHED;
            PG8_LDA(At, 0, 1); PG8_STAGE(PG8_SB(0, 0), b2, voffB); PG8_STAGE(PG8_SB(0, 1), b2 + hstepB, voffB); PG8_STAGE(PG8_SA(0, 0), a2, voffA);
            PG8_WAIT_V(8); PG8_WAIT_L(0); PG8_BAR; PG8_MMA(1, 0, At, B0); PG8_MMA(1, 1, At, B1); PG8_BAR; PG8_SCHED;
            PG8_LDB(B0, 1, 0); PG8_LDB(B1, 1, 1); PG8_SCHED; PG8_LDA(At, 1, 0); PG8_STAGE(PG8_SA(0, 1), a2 + hstepA, voffA);
            PG8_WAIT_V(8); PG8_WAIT_L(0); PG8_BAR; PG8_MMA(0, 0, At, B0); PG8_MMA(0, 1, At, B1); PG8_BAR; PG8_SCHED;
            PG8_LDA(At, 1, 1); PG8_STAGE(PG8_SB(1, 0), b3, voffB); PG8_STAGE(PG8_SB(1, 1), b3 + hstepB, voffB); PG8_STAGE(PG8_SA(1, 0), a3, voffA);
            PG8_WAIT_V(8); PG8_WAIT_L(0); PG8_BAR; PG8_MMA(1, 0, At, B0); PG8_MMA(1, 1, At, B1); PG8_BAR; PG8_SCHED;
            } else {
            PG8_LDB(B0, 0, 0); PG8_SCHED; PG8_LDA(At, 0, 0); PG8_STAGE(PG8_SA(1, 1), a1 + hstepA, voffA);
            PG8_WAIT_L(8); PG8_BAR; PG8_WAIT_L(0); PG8_MMA(0, 0, At, B0); PG8_BAR; PG8_SCHED;
            PG8_LDB(B1, 0, 1); PG8_STAGE(PG8_SB(0, 0), b2, voffB);
            PG8_BAR; PG8_WAIT_L(0); PG8_MMA(0, 1, At, B1); PG8_BAR;
            PG8_LDA(At, 0, 1); PG8_STAGE(PG8_SA(0, 0), a2, voffA);
            PG8_BAR; PG8_WAIT_L(0); PG8_MMA(1, 0, At, B0); PG8_BAR; PG8_SCHED;
            PG8_STAGE(PG8_SB(0, 1), b2 + hstepB, voffB);
            PG8_WAIT_V(6); PG8_BAR; PG8_MMA(1, 1, At, B1); PG8_BAR;
            PG8_LDB(B0, 1, 0); PG8_SCHED; PG8_LDA(At, 1, 0); PG8_STAGE(PG8_SA(0, 1), a2 + hstepA, voffA);
            PG8_WAIT_L(8); PG8_BAR; PG8_WAIT_L(0); PG8_MMA(0, 0, At, B0); PG8_BAR; PG8_SCHED;
            PG8_LDB(B1, 1, 1); PG8_STAGE(PG8_SB(1, 0), b3, voffB);
            PG8_BAR; PG8_WAIT_L(0); PG8_MMA(0, 1, At, B1); PG8_BAR;
            PG8_LDA(At, 1, 1); PG8_STAGE(PG8_SA(1, 0), a3, voffA);
            PG8_BAR; PG8_WAIT_L(0); PG8_MMA(1, 0, At, B0); PG8_BAR; PG8_SCHED;
            PG8_STAGE(PG8_SB(1, 1), b3 + hstepB, voffB);
            PG8_WAIT_V(6); PG8_BAR; PG8_MMA(1, 1, At, B1); PG8_BAR;
            }
        }
        if constexpr (ALIGN_EPI) { if (wr == 0) PG8_BAR; }
        bool keep_acc = false;
        if constexpr (Epi::TWO_STAGE) { if (cur.half == 0) { E.mid(acc, cur, wr, wc, fr, fq); keep_acc = true; } else E(acc, cur, wr, wc, fr, fq); }
        else if constexpr (!Epi::AFTER_DRAIN) { E(acc, cur, wr, wc, fr, fq); S.done(cur); }
        if (!has_next) break;
        if (!keep_acc)
#pragma unroll
        for (int a = 0; a < 2; ++a)
#pragma unroll
            for (int b = 0; b < 2; ++b)
#pragma unroll
                for (int m = 0; m < 4; ++m)
#pragma unroll
                    for (int n = 0; n < 2; ++n) acc[a][b][m][n] = (f32x4){0.f, 0.f, 0.f, 0.f};
        cur = nxt; cA = nA; cB = nB; ++ui;
        if constexpr (ALIGN_EPI) { if (wr == 1) PG8_BAR; }
    }
    PG8_WAIT_V(0);
    if constexpr (!ALIGN_EPI) { if (wr == 0) PG8_BAR; }
    PG8_BAR;
#undef PG8_SA
#undef PG8_SB
#undef PG8_STAGE
#undef PG8_LDA
#undef PG8_LDB
#undef PG8_MMA
#undef PG8_WAIT_V
#undef PG8_WAIT_L
#undef PG8_BAR
#undef PG8_SCHED
}
}

using pg8::bf16_t; using pg8::bf16x8; using pg8::f32x4; using pg8::u32x4; using pg8::u32x2; using pg8::cvtpk; using pg8::bflo; using pg8::bfhi; using pg8::sigmoidf_; using pg8::siluf_;
typedef float f32x16 __attribute__((ext_vector_type(16)));
typedef short s16x4 __attribute__((ext_vector_type(4)));
typedef short v4i16_t __attribute__((ext_vector_type(4)));
#define LAS __attribute__((address_space(3)))
#define MFMA32(a, b, c) __builtin_amdgcn_mfma_f32_32x32x16_bf16((a), (b), (c), 0, 0, 0)

constexpr int NWAVES = 8, NTHR = 512;
constexpr int MTOK = 16384, DM = 2048, SEQ = 8192, DFF = 5632, NIN = 17408;
constexpr float EPS = 1e-6f;
constexpr size_t MiB = 1u << 20;
constexpr size_t WS_BAR = 65536, WS_BAR_BYTES = 16384;
constexpr size_t WS_R2 = 327680;
constexpr size_t WS_RSTD0 = 262144;
constexpr size_t WS_LB = 0, WS_LSE = 1 * MiB, WS_DEC = 3 * MiB, WS_ROPE = 4 * MiB, WS_WIN = 8 * MiB, WS_XN = 76 * MiB, WS_Q = 140 * MiB, WS_K = 236 * MiB, WS_V = 332 * MiB, WS_S = 428 * MiB;
constexpr size_t WS_WPA = 8 * MiB, WS_WPR = 12 * MiB, WS_WO = 16 * MiB, WS_WDN = 24 * MiB;
constexpr size_t WS_WING = WS_WIN + (size_t)13312 * 2048 * 2;
constexpr size_t WS_G = 236 * MiB, WS_WGU = 364 * MiB;
constexpr size_t WS_Y = WS_S, WS_Z = 236 * MiB, WS_A2 = WS_XN, WS_FFH = 140 * MiB, WS_Z2 = 316 * MiB;
constexpr size_t WS_END = 492 * MiB;
constexpr int LDS_BYTES = 147456;

struct Args { const float* in[13]; float* out; unsigned char* ws; float inv_freq[64]; };

__device__ __forceinline__ int crow(int reg, int h) { return (reg & 3) + 8 * (reg >> 2) + 4 * h; }
__device__ __forceinline__ float wave_sum(float v) {
#pragma unroll
    for (int o = 1; o < 64; o <<= 1) v += __shfl_xor(v, o);
    return v;
}
__device__ __forceinline__ bf16x8 pack8(const f32x16& x, int s8) {
    u32x4 p; p.x = cvtpk(x[s8 + 0], x[s8 + 1]); p.y = cvtpk(x[s8 + 2], x[s8 + 3]); p.z = cvtpk(x[s8 + 4], x[s8 + 5]); p.w = cvtpk(x[s8 + 6], x[s8 + 7]);
    return __builtin_bit_cast(bf16x8, p);
}
__device__ __forceinline__ s16x4 trd(const LAS unsigned char* p) { return __builtin_bit_cast(s16x4, __builtin_amdgcn_ds_read_tr16_b64_v4i16((LAS v4i16_t*)p)); }


#define XB_TMO      128
#define XB_XCNT(j)  (256  + 64 * (j))
#define XB_XSUB(j)  (1280 + 64 * (j))
#define XB_XGEN(j)  (2304 + 64 * (j))
#define XB_TOP      3328
#define XB_TOPGEN   3392
#define XCD_BAR_WORDS 3456
#define XB_SPIN_CAP (1u << 20)
__device__ __forceinline__ unsigned xb_ld(unsigned* p)              { return __hip_atomic_load(p, __ATOMIC_RELAXED, __HIP_MEMORY_SCOPE_AGENT); }
__device__ __forceinline__ unsigned xb_add(unsigned* p, unsigned v) { return __hip_atomic_fetch_add(p, v, __ATOMIC_RELAXED, __HIP_MEMORY_SCOPE_AGENT); }
__device__ __forceinline__ unsigned xb_xcc_id() { return (unsigned)__builtin_amdgcn_s_getreg((3 << 11) | 20) & 0xFu; }
#define XB_SPIN(cond, bar) do { unsigned _sp = 0; while (cond) { __builtin_amdgcn_s_sleep(1); \
    if ((++_sp & 255u) == 0u) { if (xb_ld(&(bar)[XB_TMO])) break; if (_sp > XB_SPIN_CAP) { atomicAdd(&(bar)[XB_TMO], 1u); break; } } } } while (0)
struct XcdBarrier { unsigned* bar; unsigned x; volatile LAS unsigned* st; };
__device__ __forceinline__ XcdBarrier xcd_barrier_post(unsigned* bar, volatile LAS unsigned* st) {
    XcdBarrier b; b.bar = bar; b.x = xb_xcc_id(); b.st = st;
    if (threadIdx.x == 0) (void)xb_add(&bar[XB_XCNT(b.x)], 1u);
    return b;
}
__device__ __forceinline__ void xcd_barrier_complete(unsigned* bar, unsigned x, unsigned& nloc, unsigned& nx) {
    const unsigned G = gridDim.x * gridDim.y * gridDim.z;
    unsigned sum, cnt, mine, sp = 0u;
    for (;;) {
        sum = 0u; cnt = 0u; mine = 0u;
#pragma unroll
        for (unsigned j = 0; j < 16; ++j) { const unsigned c = xb_ld(&bar[XB_XCNT(j)]); sum += c; cnt += (c > 0u) ? 1u : 0u; mine = (j == x) ? c : mine; }
        if (sum == G) break;
        __builtin_amdgcn_s_sleep(1);
        if ((++sp & 255u) == 0u) { if (xb_ld(&bar[XB_TMO])) break; if (sp > XB_SPIN_CAP) { atomicAdd(&bar[XB_TMO], 1u); break; } }
    }
    nloc = mine > 0u ? mine : 1u; nx = cnt > 0u ? cnt : 1u;
}
__device__ __forceinline__ void xcd_barrier(const XcdBarrier& b) {
    asm volatile("s_waitcnt vmcnt(0)" ::: "memory");
    __syncthreads();
    if (threadIdx.x == 0) {
        unsigned* bar = b.bar;
        __builtin_amdgcn_s_waitcnt(0);
        unsigned nloc = b.st[0], nx = b.st[1];
        if (nloc == 0u) { xcd_barrier_complete(bar, b.x, nloc, nx); b.st[0] = nloc; b.st[1] = nx; }
        const unsigned old = xb_add(&bar[XB_XSUB(b.x)], 1u);
        const unsigned gen = old / nloc;
        if (old + 1u == (gen + 1u) * nloc) {
            __builtin_amdgcn_fence(__ATOMIC_RELEASE, "agent");
            asm volatile("s_waitcnt vmcnt(0)" ::: "memory");
            const unsigned og = xb_add(&bar[XB_TOP], 1u);
            const unsigned tg = og / nx;
            if (og + 1u == (tg + 1u) * nx) xb_add(&bar[XB_TOPGEN], 1u);
            else XB_SPIN(xb_ld(&bar[XB_TOPGEN]) == tg, bar);
            __builtin_amdgcn_fence(__ATOMIC_ACQUIRE, "agent");
            xb_add(&bar[XB_XGEN(b.x)], 1u);
            asm volatile("s_waitcnt vmcnt(0)" ::: "memory");
        } else {
            XB_SPIN(xb_ld(&bar[XB_XGEN(b.x)]) == gen, bar);
            __builtin_amdgcn_fence(__ATOMIC_ACQUIRE, "agent");
            asm volatile("s_waitcnt vmcnt(0)" ::: "memory");
        }
    }
    __syncthreads();
}

template <int MODE> __device__ __forceinline__ int wmap(int n) {
    if (MODE == 1) { if (n < 6144) { const int pn = n >> 8, x = n & 255, hh = x >> 7, dd = x & 127, bj = dd >> 6, dl = dd & 63; return (pn << 8) + (bj << 7) + (hh << 6) + dl; } return n; }
    if (MODE == 2) { const int up = n >= DFF ? 1 : 0; const int j = up ? n - DFF : n; return ((j >> 7) << 8) + (up << 7) + (j & 127); }
    return n;
}
template <int MODE> __device__ __forceinline__ void transpose_load(const float* W, int N, int item, int lane, float (&v)[32]) {
    const int nblk = N / 32, kb = item / nblk, nb = item % nblk, k0 = 64 * kb, n0 = 32 * nb;
    const float* p = W + (size_t)(k0 + (lane >> 5)) * N + n0 + (lane & 31);
#pragma unroll
    for (int i = 0; i < 32; ++i) v[i] = p[(size_t)(2 * i) * N];
}
template <int MODE> __device__ __forceinline__ void transpose_store(const float (&v)[32], int K, int N, bf16_t* WT, LAS float* scr, int item, int lane, const float* ksc) {
    const int nblk = N / 32, kb = item / nblk, nb = item % nblk, k0 = 64 * kb, n0 = 32 * nb;
#pragma unroll
    for (int i = 0; i < 32; ++i) { const int kk = 2 * i + (lane >> 5); scr[kk * 33 + (lane & 31)] = v[i]; }
    asm volatile("s_waitcnt lgkmcnt(0)" ::: "memory");
    const int c = lane & 7; const int d0 = wmap<MODE>(n0);
    f32x4 ka = (f32x4){1.f, 1.f, 1.f, 1.f}, kb_ = ka;
    if (MODE == 2) { ka = *(const f32x4*)(ksc + k0 + 8 * c); kb_ = *(const f32x4*)(ksc + k0 + 8 * c + 4); }
#pragma unroll
    for (int j = 0; j < 4; ++j) { const int n = (lane >> 3) + 8 * j; const LAS float* s = scr + (8 * c) * 33 + n;
        u32x4 o; o.x = cvtpk(s[0 * 33] * ka[0], s[1 * 33] * ka[1]); o.y = cvtpk(s[2 * 33] * ka[2], s[3 * 33] * ka[3]); o.z = cvtpk(s[4 * 33] * kb_[0], s[5 * 33] * kb_[1]); o.w = cvtpk(s[6 * 33] * kb_[2], s[7 * 33] * kb_[3]);
        *(u32x4*)(WT + (size_t)(d0 + n) * K + k0 + 8 * c) = o; }
    asm volatile("s_waitcnt lgkmcnt(0)" ::: "memory");
}
template <int MODE> __device__ __forceinline__ void transpose_all(const float* W, int K, int N, bf16_t* WT, LAS unsigned char* lds, int gw, int ngw, int wave, int lane, const float* ksc = nullptr) {
    LAS float* scr = (LAS float*)(lds + wave * 16384);
    const int nitems = (K / 64) * (N / 32);
    float cur[32], nxt[32];
    if (gw < nitems) transpose_load<MODE>(W, N, gw, lane, cur);
    for (int it = gw; it < nitems; it += ngw) {
        const bool more = it + ngw < nitems;
        if (more) transpose_load<MODE>(W, N, it + ngw, lane, nxt);
        transpose_store<MODE>(cur, K, N, WT, scr, it, lane, ksc);
        if (more) {
#pragma unroll
            for (int i = 0; i < 32; ++i) cur[i] = nxt[i];
        }
    }
}

__device__ __forceinline__ void attn_unit(LAS unsigned char* lds, int a, const bf16_t* Qm, const bf16_t* Km, const bf16_t* Vm, bf16_t* Om, float* lse) {
    const int tid = threadIdx.x, lane = tid & 63, wid = __builtin_amdgcn_readfirstlane(tid >> 6), r = lane & 31, h = lane >> 5;
    const int g = a >> 10; int rem = a & 1023; const int b = rem >> 9; rem &= 511; const int hd = rem >> 6, blk = rem & 63;
    const int dsh = 2 * g, nsh = 6 - dsh;
    const int res = blk >> nsh, ub = blk & ((1 << nsh) - 1), u0 = ub * 128;
    const int col = (g * 8 + hd) * 128;
    const size_t rowbase = (size_t)b * SEQ + res;
    LAS unsigned char* Ks = lds; LAS unsigned char* Vs = lds + 65536;
    const int kk_lo = (u0 == 0) ? 128 : 0;
    {
        u32x4 kvr[8], vvr[8];
#pragma unroll
        for (int i = 0; i < 8; ++i) {
            const int idx = tid + 512 * i, kk = idx >> 4, c = idx & 15;
            const int uu = u0 - 128 + (kk < kk_lo ? kk_lo : kk);
            const size_t grow = rowbase + ((size_t)uu << dsh);
            kvr[i] = *(const u32x4*)(Km + grow * 3072 + col + c * 8);
            vvr[i] = *(const u32x4*)(Vm + grow * 3072 + col + c * 8);
        }
#pragma unroll
        for (int i = 0; i < 8; ++i) {
            const int idx = tid + 512 * i, kk = idx >> 4, c = idx & 15;
            *(LAS u32x4*)(Ks + kk * 256 + ((c ^ (kk & 15)) << 4)) = kvr[i];
            *(LAS u32x4*)(Vs + kk * 256 + (((c >> 1) ^ (kk & 7)) << 5) + ((c & 1) << 4)) = vvr[i];
        }
    }
    const int qj = lane & 15, qd = lane >> 4;
    const size_t qrow = rowbase + ((size_t)(u0 + 16 * wid + qj) << dsh);
    bf16x8 qf[4];
#pragma unroll
    for (int ks = 0; ks < 4; ++ks) qf[ks] = __builtin_bit_cast(bf16x8, *(const u32x4*)(Qm + qrow * 3072 + col + 32 * ks + 8 * qd));
    __syncthreads();
    f32x4 sc[9];
    const int tskip = (u0 == 0) ? (8 - wid) : 0;
#pragma unroll
    for (int t = 0; t < 9; ++t) {
        f32x4 acc = (f32x4){0.f, 0.f, 0.f, 0.f};
        if (t >= tskip) {
            const int kr = 16 * wid + 16 * t + qj;
#pragma unroll
            for (int ks = 0; ks < 4; ++ks) { const bf16x8 kf = *(const LAS bf16x8*)(Ks + kr * 256 + (((4 * ks + qd) ^ (kr & 15)) << 4)); acc = __builtin_amdgcn_mfma_f32_16x16x32_bf16(kf, qf[ks], acc, 0, 0, 0); }
        } else acc = (f32x4){-INFINITY, -INFINITY, -INFINITY, -INFINITY};
        sc[t] = acc;
    }
#pragma unroll
    for (int e = 0; e < 4; ++e) { if (4 * qd + e < qj) sc[0][e] = -INFINITY; if (4 * qd + e > qj) sc[8][e] = -INFINITY; }
    float mx = sc[8][0];
#pragma unroll
    for (int t = 0; t < 9; ++t)
#pragma unroll
        for (int e = 0; e < 4; ++e) mx = fmaxf(mx, sc[t][e]);
    mx = fmaxf(mx, __shfl_xor(mx, 16)); mx = fmaxf(mx, __shfl_xor(mx, 32));
    float l = 0.f;
#pragma unroll
    for (int t = 0; t < 9; ++t)
#pragma unroll
        for (int e = 0; e < 4; ++e) { sc[t][e] = __builtin_amdgcn_exp2f(sc[t][e] - mx); l += sc[t][e]; }
    l += __shfl_xor(l, 16); l += __shfl_xor(l, 32);
    f32x4 o[8];
#pragma unroll
    for (int db = 0; db < 8; ++db) o[db] = (f32x4){0.f, 0.f, 0.f, 0.f};
    const int q4 = (lane & 15) >> 2, p4 = lane & 3;
#pragma unroll
    for (int st = 0; st < 5; ++st) {
        if (2 * st + 1 < tskip) continue;
        u32x4 pw; pw.x = cvtpk(sc[2 * st][0], sc[2 * st][1]); pw.y = cvtpk(sc[2 * st][2], sc[2 * st][3]);
        if (st < 4) { pw.z = cvtpk(sc[2 * st + 1][0], sc[2 * st + 1][1]); pw.w = cvtpk(sc[2 * st + 1][2], sc[2 * st + 1][3]); } else { pw.z = 0u; pw.w = 0u; }
        const bf16x8 pb = __builtin_bit_cast(bf16x8, pw);
        const int key0 = 16 * wid + 32 * st + 4 * qd + q4;
        const int key1 = (st < 4) ? key0 + 16 : key0;
#pragma unroll
        for (int db = 0; db < 8; ++db) {
            const int so = ((db ^ (key0 & 7)) << 5) + 8 * p4;
            const s16x4 lo = trd(Vs + key0 * 256 + so), hi = trd(Vs + key1 * 256 + so);
            const bf16x8 af = __builtin_shufflevector(lo, hi, 0, 1, 2, 3, 4, 5, 6, 7);
            o[db] = __builtin_amdgcn_mfma_f32_16x16x32_bf16(af, pb, o[db], 0, 0, 0);
        }
    }
    const float inv = 1.f / l;
    __syncthreads();
    LAS unsigned char* stg = lds + wid * 4608;
#pragma unroll
    for (int db = 0; db < 8; ++db) {
        u32x2 w; w.x = cvtpk(o[db][0] * inv, o[db][1] * inv); w.y = cvtpk(o[db][2] * inv, o[db][3] * inv);
        *(LAS u32x2*)(stg + qj * 272 + (16 * db + 4 * qd) * 2) = w;
    }
    asm volatile("s_waitcnt lgkmcnt(0)" ::: "memory");
#pragma unroll
    for (int ps = 0; ps < 4; ++ps) {
        const int row = ps * 4 + (lane >> 4), ch = lane & 15;
        const u32x4 v = *(const LAS u32x4*)(stg + row * 272 + ch * 16);
        const size_t grow = rowbase + ((size_t)(u0 + 16 * wid + row) << dsh);
        *(u32x4*)(Om + grow * 3072 + col + ch * 8) = v;
    }
    if (qd == 0) lse[((size_t)g * MTOK + qrow) * 8 + hd] = mx + __builtin_amdgcn_logf(l);
    __syncthreads();
}

constexpr int HL_GB = 0, HL_PP = 33024, HL_RED = 35072, HL_QT = 36864, HL_KT = 53248, HL_KHT = 69632, HL_VT = 86016, HL_STG = 102400;
template <bool PASS_A> __device__ __forceinline__ void hgrn_setup(LAS unsigned char* lds, int b, int hd, int c, const bf16_t* HG, const float* LB) {
    const int tid = threadIdx.x;
    LAS float* GB = (LAS float*)(lds + HL_GB); LAS float* PP = (LAS float*)(lds + HL_PP);
    const size_t row0 = (size_t)b * SEQ + (size_t)c * 64;
#pragma unroll
    for (int i = 0; i < 2; ++i) {
        const int q = tid + 512 * i, t = q >> 4, cc = q & 15;
        const bf16_t* rp = HG + (row0 + t) * 4096 + hd * 128 + cc * 8;
        const u32x4 fw = *(const u32x4*)(rp + 1024), iw = *(const u32x4*)(rp + 2048);
        if (!PASS_A) { const u32x4 qw = *(const u32x4*)(rp); *(LAS u32x4*)(lds + HL_QT + t * 256 + ((cc ^ (t & 15)) << 4)) = qw; }
        *(LAS u32x4*)(lds + HL_KT + t * 256 + ((cc ^ (t & 15)) << 4)) = fw;
        *(LAS u32x4*)(lds + HL_STG + t * 272 + cc * 16) = iw;
    }
    __syncthreads();
    float omr[2][8];
#pragma unroll
    for (int i = 0; i < 2; ++i) {
        const int q = tid + 512 * i, t = q & 63, cc = q >> 6;
        const u32x4 fw = *(const LAS u32x4*)(lds + HL_KT + t * 256 + ((cc ^ (t & 15)) << 4));
        const unsigned fws[4] = {fw.x, fw.y, fw.z, fw.w};
#pragma unroll
        for (int e = 0; e < 8; ++e) {
            const float x = (e & 1) ? bfhi(fws[e >> 1]) : bflo(fws[e >> 1]);
            const float lbv = LB[hd * 128 + cc * 8 + e];
            const float ef = __builtin_amdgcn_exp2f(-1.4426950408889634f * x), sg = __builtin_amdgcn_rcpf(1.f + ef);
            const float f = lbv + (1.f - lbv) * sg;
            omr[i][e] = (1.f - lbv) * ef * sg;
            GB[t * 129 + cc * 8 + e] = __builtin_amdgcn_logf(f);
        }
    }
    __syncthreads();
    {
        const int k = tid & 127, part = tid >> 7; float accv = 0.f;
#pragma unroll
        for (int j = 0; j < 16; ++j) { const int t = 16 * part + j; accv += GB[t * 129 + k]; GB[t * 129 + k] = accv; }
        PP[part * 128 + k] = accv;
        __syncthreads();
        float off = 0.f;
        for (int pp = 0; pp < part; ++pp) off += PP[pp * 128 + k];
        if (part > 0) {
#pragma unroll
            for (int j = 0; j < 16; ++j) { const int t = 16 * part + j; GB[t * 129 + k] += off; }
        }
        if (part == 0) ((LAS float*)(lds + HL_RED))[k] = (PP[k] + PP[128 + k]) + (PP[256 + k] + PP[384 + k]);
    }
    __syncthreads();
#pragma unroll
    for (int i = 0; i < 2; ++i) {
        const int q = tid + 512 * i, t = q & 63, cc = q >> 6;
        const u32x4 qw = *(const LAS u32x4*)(lds + HL_QT + t * 256 + ((cc ^ (t & 15)) << 4)), fw = *(const LAS u32x4*)(lds + HL_KT + t * 256 + ((cc ^ (t & 15)) << 4)),
                    iw = *(const LAS u32x4*)(lds + HL_STG + t * 272 + cc * 16);
        const unsigned qws[4] = {qw.x, qw.y, qw.z, qw.w}, fws[4] = {fw.x, fw.y, fw.z, fw.w}, iws[4] = {iw.x, iw.y, iw.z, iw.w};
        float qt[8], kt[8];
#pragma unroll
        for (int e = 0; e < 8; ++e) {
            const int k = cc * 8 + e;
            const float bb = GB[t * 129 + k];
            const float om = omr[i][e];
            if (PASS_A) {
                const float bl = ((const LAS float*)(lds + HL_RED))[k];
                const float kh = om * __builtin_amdgcn_exp2f(bl - bb);
                const unsigned khb = cvtpk(kh, 0.f) & 0xffffu;
                *(LAS unsigned short*)(lds + HL_KHT + k * 128 + (((t >> 3) ^ (k & 7)) << 4) + (t & 7) * 2) = (unsigned short)khb;
            } else {
                const float qx = (e & 1) ? bfhi(qws[e >> 1]) : bflo(qws[e >> 1]);
                const float eb = __builtin_amdgcn_exp2f(bb), eq1 = 1.f + __builtin_amdgcn_exp2f(-1.4426950408889634f * qx);
                const float rr = __builtin_amdgcn_rcpf(eb * eq1);
                qt[e] = qx * eb * (rr * eb);
                kt[e] = om * (rr * eq1);
            }
            const unsigned iv = (e & 1) ? (iws[e >> 1] >> 16) : (iws[e >> 1] & 0xffffu);
            *(LAS unsigned short*)(lds + HL_VT + k * 128 + (((t >> 3) ^ (k & 7)) << 4) + (t & 7) * 2) = (unsigned short)iv;
        }
        if (!PASS_A) {
            u32x4 w; w.x = cvtpk(qt[0], qt[1]); w.y = cvtpk(qt[2], qt[3]); w.z = cvtpk(qt[4], qt[5]); w.w = cvtpk(qt[6], qt[7]);
            *(LAS u32x4*)(lds + HL_QT + t * 256 + ((cc ^ (t & 15)) << 4)) = w;
            w.x = cvtpk(kt[0], kt[1]); w.y = cvtpk(kt[2], kt[3]); w.z = cvtpk(kt[4], kt[5]); w.w = cvtpk(kt[6], kt[7]);
            *(LAS u32x4*)(lds + HL_KT + t * 256 + ((cc ^ (t & 15)) << 4)) = w;
        }
    }
    __syncthreads();
}
__device__ __forceinline__ void hgrn_pass_a(LAS unsigned char* lds, int unit, const bf16_t* HG, const float* LB, bf16_t* S, float* DEC) {
    const int tid = threadIdx.x, lane = tid & 63, wid = __builtin_amdgcn_readfirstlane(tid >> 6), r = lane & 31, h = lane >> 5;
    const int b = unit >> 10, hd = (unit >> 7) & 7, c = unit & 127;
    hgrn_setup<true>(lds, b, hd, c, HG, LB);
    const int vb = wid >> 1;
    bf16_t* Sg = S + (size_t)unit * 16384;
#pragma unroll
    for (int kbi = 0; kbi < 2; ++kbi) {
        const int kb = 2 * (wid & 1) + kbi;
        f32x16 acc;
#pragma unroll
        for (int i = 0; i < 16; ++i) acc[i] = 0.f;
        const int v = 32 * vb + r, k = 32 * kb + r;
#pragma unroll
        for (int ts = 0; ts < 4; ++ts) {
            const int ch = 2 * ts + h;
            const bf16x8 af = *(const LAS bf16x8*)(lds + HL_VT + v * 128 + ((ch ^ (v & 7)) << 4));
            const bf16x8 bf = *(const LAS bf16x8*)(lds + HL_KHT + k * 128 + ((ch ^ (k & 7)) << 4));
            acc = MFMA32(af, bf, acc);
        }
#pragma unroll
        for (int i = 0; i < 16; ++i) *(LAS unsigned short*)(lds + HL_GB + (32 * vb + crow(i, h)) * 256 + k * 2) = (unsigned short)(cvtpk(acc[i], 0.f) & 0xffffu);
    }
    __syncthreads();
#pragma unroll
    for (int i = 0; i < 4; ++i) { const int q = tid + 512 * i; *(u32x4*)(Sg + q * 8) = *(const LAS u32x4*)(lds + HL_GB + q * 16); }
    if (tid < 128) DEC[(size_t)unit * 128 + tid] = __builtin_amdgcn_exp2f(((const LAS float*)(lds + HL_RED))[tid]);
    __syncthreads();
}
__device__ __forceinline__ void hgrn_pass_c(LAS unsigned char* lds, int unit, bf16_t* HG, const float* LB, const bf16_t* S, const float* hgain, const bf16_t* Og, const float* lse) {
    const int tid = threadIdx.x, lane = tid & 63, wid = __builtin_amdgcn_readfirstlane(tid >> 6), r = lane & 31, h = lane >> 5;
    const int b = unit >> 10, hd = (unit >> 7) & 7, c = unit & 127;
    hgrn_setup<false>(lds, b, hd, c, HG, LB);
    const int vb = wid >> 1, tb = wid & 1;
    const bf16_t* Sg = S + (size_t)unit * 16384;
    f32x16 o;
#pragma unroll
    for (int i = 0; i < 16; ++i) o[i] = 0.f;
    const int trow = 32 * tb + r, vrow = 32 * vb + r;
    bf16x8 qf[8];
#pragma unroll
    for (int ks = 0; ks < 8; ++ks) qf[ks] = *(const LAS bf16x8*)(lds + HL_QT + trow * 256 + (((2 * ks + h) ^ (trow & 15)) << 4));
#pragma unroll
    for (int ks = 0; ks < 8; ++ks) { const bf16x8 af = __builtin_bit_cast(bf16x8, *(const u32x4*)(Sg + vrow * 128 + 16 * ks + 8 * h)); o = MFMA32(af, qf[ks], o); }
    for (int sb = 0; sb <= tb; ++sb) {
        f32x16 X;
#pragma unroll
        for (int i = 0; i < 16; ++i) X[i] = 0.f;
        const int srow = 32 * sb + r;
#pragma unroll
        for (int ks = 0; ks < 8; ++ks) { const bf16x8 af = *(const LAS bf16x8*)(lds + HL_KT + srow * 256 + (((2 * ks + h) ^ (srow & 15)) << 4)); X = MFMA32(af, qf[ks], X); }
        if (sb == tb) {
#pragma unroll
            for (int i = 0; i < 16; ++i) if (crow(i, h) > r) X[i] = 0.f;
        }
#pragma unroll
        for (int ss = 0; ss < 2; ++ss) {
            const bf16x8 pb = pack8(X, 8 * ss);
            const int c0 = 4 * sb + 2 * ss;
            const u32x2 lo = *(const LAS u32x2*)(lds + HL_VT + vrow * 128 + ((c0 ^ (vrow & 7)) << 4) + 8 * h);
            const u32x2 hi = *(const LAS u32x2*)(lds + HL_VT + vrow * 128 + (((c0 + 1) ^ (vrow & 7)) << 4) + 8 * h);
            u32x4 aw; aw.x = lo.x; aw.y = lo.y; aw.z = hi.x; aw.w = hi.y;
            o = MFMA32(__builtin_bit_cast(bf16x8, aw), pb, o);
        }
    }
    float ssq = 0.f;
#pragma unroll
    for (int i = 0; i < 16; ++i) ssq += o[i] * o[i];
    ssq += __shfl_xor(ssq, 32);
    LAS float* RED = (LAS float*)(lds + HL_RED);
    if (h == 0) RED[vb * 64 + trow] = ssq;
    __syncthreads();
    const float tot = (RED[trow] + RED[64 + trow]) + (RED[128 + trow] + RED[192 + trow]);
    const float rstd = rsqrtf(tot * (1.f / 128.f) + EPS);
#pragma unroll
    for (int gq = 0; gq < 4; ++gq) {
        u32x2 w; w.x = cvtpk(o[4 * gq] * rstd, o[4 * gq + 1] * rstd); w.y = cvtpk(o[4 * gq + 2] * rstd, o[4 * gq + 3] * rstd);
        *(LAS u32x2*)(lds + HL_STG + trow * 272 + (32 * vb + 8 * gq + 4 * h) * 2) = w;
    }
    __syncthreads();
    const size_t row0 = (size_t)b * SEQ + (size_t)c * 64;
#pragma unroll
    for (int i = 0; i < 2; ++i) {
        const int q = tid + 512 * i, t = q >> 4, cc = q & 15;
        const size_t row = row0 + t;
        bf16_t* rp = HG + row * 4096 + hd * 128 + cc * 8;
        const u32x4 ov = *(const LAS u32x4*)(lds + HL_STG + t * 272 + cc * 16);
        const u32x4 gw = *(const u32x4*)(rp + 3072);
        const f32x4 ga = *(const f32x4*)(hgain + hd * 128 + cc * 8), gb = *(const f32x4*)(hgain + hd * 128 + cc * 8 + 4);
        const float gn[8] = {ga[0], ga[1], ga[2], ga[3], gb[0], gb[1], gb[2], gb[3]};
        const unsigned ovs[4] = {ov.x, ov.y, ov.z, ov.w}, gws[4] = {gw.x, gw.y, gw.z, gw.w};
        float ro[8];
#pragma unroll
        for (int e = 0; e < 4; ++e) { ro[2 * e] = bflo(ovs[e]) * gn[2 * e] * siluf_(bflo(gws[e])); ro[2 * e + 1] = bfhi(ovs[e]) * gn[2 * e + 1] * siluf_(bfhi(gws[e])); }
        const float l0 = lse[((size_t)0 * MTOK + row) * 8 + hd], l1 = lse[((size_t)1 * MTOK + row) * 8 + hd], l2 = lse[((size_t)2 * MTOK + row) * 8 + hd];
        const float mx = fmaxf(l0, fmaxf(l1, l2));
        float w0 = __builtin_amdgcn_exp2f(l0 - mx), w1 = __builtin_amdgcn_exp2f(l1 - mx), w2 = __builtin_amdgcn_exp2f(l2 - mx);
        const float wi = 1.f / (w0 + w1 + w2); w0 *= wi; w1 *= wi; w2 *= wi;
        const bf16_t* op = Og + row * 3072 + hd * 128 + cc * 8;
        const u32x4 a0 = *(const u32x4*)(op), a1 = *(const u32x4*)(op + 1024), a2 = *(const u32x4*)(op + 2048);
        const unsigned a0s[4] = {a0.x, a0.y, a0.z, a0.w}, a1s[4] = {a1.x, a1.y, a1.z, a1.w}, a2s[4] = {a2.x, a2.y, a2.z, a2.w};
        u32x4 wr_, wa_;
        unsigned wrs[4], was[4];
#pragma unroll
        for (int e = 0; e < 4; ++e) {
            wrs[e] = cvtpk(ro[2 * e], ro[2 * e + 1]);
            was[e] = cvtpk(w0 * bflo(a0s[e]) + w1 * bflo(a1s[e]) + w2 * bflo(a2s[e]), w0 * bfhi(a0s[e]) + w1 * bfhi(a1s[e]) + w2 * bfhi(a2s[e]));
        }
        wr_.x = wrs[0]; wr_.y = wrs[1]; wr_.z = wrs[2]; wr_.w = wrs[3];
        wa_.x = was[0]; wa_.y = was[1]; wa_.z = was[2]; wa_.w = was[3];
        *(u32x4*)(rp) = wr_;
        *(u32x4*)(rp + 1024) = wa_;
    }
    __syncthreads();
}

__global__ void __launch_bounds__(NTHR, 2) fwd_megakernel(Args args) {
    extern __shared__ __attribute__((aligned(16))) unsigned char lds_raw[];
    cg::grid_group grid = cg::this_grid();
    LAS unsigned char* lds = (LAS unsigned char*)lds_raw;
    const int tid = threadIdx.x, lane = tid & 63, wave = __builtin_amdgcn_readfirstlane(tid >> 6);
    const int G = gridDim.x, bx = blockIdx.x;
    const int gw = bx * NWAVES + wave, ngw = G * NWAVES;
    unsigned char* ws = args.ws;
    if (args.out == nullptr) grid.sync();
    volatile LAS unsigned* bst = (volatile LAS unsigned*)(lds + 131072 + 64);
    if (tid < 2) bst[tid] = 0u;
    __syncthreads();
    const XcdBarrier gbar = xcd_barrier_post((unsigned*)(ws + WS_BAR), bst);
    const float* x = args.in[0]; const float* w_in = args.in[1]; const float* w_pa = args.in[2]; const float* w_pr = args.in[3]; const float* w_o = args.in[4];
    const float* lbraw = args.in[5]; const float* hgain = args.in[6]; const float* g_pre = args.in[7]; const float* g_post = args.in[8];
    const float* w_gu = args.in[9]; const float* w_dn = args.in[10]; const float* g_fpre = args.in[11]; const float* g_fpost = args.in[12];
    float* out = args.out;
    float* LB = (float*)(ws + WS_LB); float* LSE = (float*)(ws + WS_LSE); float* DEC = (float*)(ws + WS_DEC); float* ROPE = (float*)(ws + WS_ROPE);
    bf16_t* WIN_T = (bf16_t*)(ws + WS_WIN); bf16_t* XN = (bf16_t*)(ws + WS_XN); bf16_t* Qb = (bf16_t*)(ws + WS_Q); bf16_t* Kb = (bf16_t*)(ws + WS_K); bf16_t* Vb = (bf16_t*)(ws + WS_V);
    bf16_t* Sb = (bf16_t*)(ws + WS_S); bf16_t* HG = (bf16_t*)out;
    bf16_t* WPA_T = (bf16_t*)(ws + WS_WPA); bf16_t* WPR_T = (bf16_t*)(ws + WS_WPR); bf16_t* WO_T = (bf16_t*)(ws + WS_WO); bf16_t* WDN_T = (bf16_t*)(ws + WS_WDN);
    bf16_t* WGU_T = (bf16_t*)(ws + WS_WGU); bf16_t* Gt = (bf16_t*)(ws + WS_G); bf16_t* Yb = (bf16_t*)(ws + WS_Y); bf16_t* Z = (bf16_t*)(ws + WS_Z);
    bf16_t* A2 = (bf16_t*)(ws + WS_A2); bf16_t* FFH = (bf16_t*)(ws + WS_FFH); bf16_t* Z2 = (bf16_t*)(ws + WS_Z2);
    float* RSTD0 = (float*)(ws + WS_RSTD0); float* R2 = (float*)(ws + WS_R2);
    bf16_t* H1B = (bf16_t*)(ws + WS_Y);

    transpose_all<1>(w_in, DM, NIN, WIN_T, lds, gw, ngw, wave, lane);
    {
    f32x4 gpre[8];
#pragma unroll
    for (int j = 0; j < 8; ++j) gpre[j] = ((const f32x4*)g_pre)[128 * (j >> 1) + 2 * lane + (j & 1)];
    for (int row = gw; row < MTOK; row += ngw) {
        const f32x4* xr = (const f32x4*)(x + (size_t)row * DM) + 2 * lane;
        f32x4 v[8]; float s = 0.f;
#pragma unroll
        for (int j = 0; j < 8; ++j) { v[j] = xr[128 * (j >> 1) + (j & 1)]; s += (v[j][0] * v[j][0] + v[j][1] * v[j][1]) + (v[j][2] * v[j][2] + v[j][3] * v[j][3]); }
        const float rstd = rsqrtf(wave_sum(s) * (1.f / DM) + EPS);
        if (lane == 0) RSTD0[row] = rstd;
        u32x4* o16 = (u32x4*)(XN + (size_t)row * DM) + lane;
#pragma unroll
        for (int jj = 0; jj < 4; ++jj) { const f32x4 g0 = gpre[2 * jj], g1 = gpre[2 * jj + 1], p = v[2 * jj], q = v[2 * jj + 1]; u32x4 w;
            w.x = cvtpk(p[0] * rstd * g0[0], p[1] * rstd * g0[1]); w.y = cvtpk(p[2] * rstd * g0[2], p[3] * rstd * g0[3]);
            w.z = cvtpk(q[0] * rstd * g1[0], q[1] * rstd * g1[1]); w.w = cvtpk(q[2] * rstd * g1[2], q[3] * rstd * g1[3]); o16[64 * jj] = w; }
    }
    }
    if (bx == 0 && tid < 64) ROPE[tid] = args.inv_freq[tid];
    if (bx == 0) for (int j = tid; j < 1024; j += NTHR) LB[j] = 1.f / (1.f + __expf(lbraw[1024 + j] - lbraw[j]));
    xcd_barrier(gbar);

    {
        pg8::Gemm g{XN, WIN_T, MTOK, 13312, DM, DM, DM}; pg8::StaticOrder S; S.init(MTOK, 13312, G, bx);
        pg8::EpiProj E{Qb, Kb, Vb, HG, ROPE};
        pg8::gemm_phase<pg8::EpiProj, pg8::StaticOrder, true, true>(lds, g, S, E);
    }
    xcd_barrier(gbar);

    {
        const int vcu = ((G & 7) == 0) ? (bx & 7) * (G >> 3) + (bx >> 3) : bx;
        for (int a = vcu; a < 3072; a += G) attn_unit(lds, a, Qb, Kb, Vb, Qb, LSE);
    }
    for (int u = bx; u < 2048; u += G) hgrn_pass_a(lds, u, HG, LB, Sb, DEC);
    xcd_barrier(gbar);

    for (int idx = bx * NTHR + tid; idx < 16 * 8192; idx += G * NTHR) {
        const int bh = idx >> 13, e2 = idx & 8191;
        unsigned* sp = (unsigned*)(Sb + (size_t)bh * 128 * 16384) + e2;
        const float* dp = DEC + (size_t)bh * 128 * 128 + ((2 * e2) & 127);
        float c0 = 0.f, c1 = 0.f;
        for (int cb = 0; cb < 128; cb += 32) {
            unsigned wv[32]; float d0v[32], d1v[32];
#pragma unroll
            for (int c = 0; c < 32; ++c) { wv[c] = sp[(size_t)(cb + c) * 8192]; d0v[c] = dp[(cb + c) * 128]; d1v[c] = dp[(cb + c) * 128 + 1]; }
#pragma unroll
            for (int c = 0; c < 32; ++c) { const unsigned w = wv[c]; wv[c] = cvtpk(c0, c1); c0 = d0v[c] * c0 + bflo(w); c1 = d1v[c] * c1 + bfhi(w); }
#pragma unroll
            for (int c = 0; c < 32; ++c) sp[(size_t)(cb + c) * 8192] = wv[c];
        }
    }
    transpose_all<0>(w_pa, 1024, DM, WPA_T, lds, gw, ngw, wave, lane);
    transpose_all<0>(w_pr, 1024, DM, WPR_T, lds, gw, ngw, wave, lane);
    transpose_all<0>(w_o, DM, DM, WO_T, lds, gw, ngw, wave, lane);
    transpose_all<0>(w_dn, DFF, DM, WDN_T, lds, gw, ngw, wave, lane);
    transpose_all<2>(w_gu, DM, 2 * DFF, WGU_T, lds, gw, ngw, wave, lane, g_fpre);
    __syncthreads();
    {
        pg8::Gemm g{XN, (const bf16_t*)(ws + WS_WING), MTOK, 4096, DM, DM, DM}; pg8::StaticOrder S; S.init(MTOK, 4096, G, bx);
        pg8::EpiPlain E{Gt, 4096};
        pg8::gemm_phase<pg8::EpiPlain, pg8::StaticOrder, true, true>(lds, g, S, E);
    }
    xcd_barrier(gbar);

    for (int u = bx; u < 2048; u += G) hgrn_pass_c(lds, u, HG, LB, Sb, hgain, Qb, LSE);
    xcd_barrier(gbar);

    {
        pg8::PairOrder S; S.init(MTOK, DM, G, bx); S.A20 = HG + 1024; S.A21 = HG; S.B20 = WPA_T; S.B21 = WPR_T;
        pg8::Gemm g{HG, WPA_T, MTOK, DM, 1024, 4096, 1024};
        pg8::EpiGate2 E{Yb, Gt};
        pg8::gemm_phase<pg8::EpiGate2, pg8::PairOrder, true, true>(lds, g, S, E);
    }
    xcd_barrier(gbar);

    {
        pg8::Gemm g{Yb, WO_T, MTOK, DM, DM, DM, DM}; pg8::StaticOrder S; S.init(MTOK, DM, G, bx);
        pg8::EpiPlain E{Z, DM};
        pg8::gemm_phase<pg8::EpiPlain, pg8::StaticOrder, true, true>(lds, g, S, E);
    }
    xcd_barrier(gbar);

    {
    int lane = threadIdx.x & 63; asm volatile("" : "+v"(lane));
    int gw = bx * NWAVES + __builtin_amdgcn_readfirstlane(threadIdx.x >> 6); asm volatile("" : "+s"(gw));
    f32x4 gpo[8], igp[8];
#pragma unroll
    for (int j = 0; j < 8; ++j) { const int gi = 128 * (j >> 1) + 2 * lane + (j & 1); gpo[j] = ((const f32x4*)g_post)[gi];
        const f32x4 gq = ((const f32x4*)g_pre)[gi]; igp[j] = (f32x4){1.f / gq[0], 1.f / gq[1], 1.f / gq[2], 1.f / gq[3]}; }
    for (int row = gw; row < MTOK; row += ngw) {
        const u32x4* zr = (const u32x4*)(Z + (size_t)row * DM) + lane; const u32x4* xr = (const u32x4*)(XN + (size_t)row * DM) + lane;
        const float ir0 = 1.f / RSTD0[row];
        u32x4 zq[4], xq[4];
#pragma unroll
        for (int jj = 0; jj < 4; ++jj) { zq[jj] = zr[64 * jj]; xq[jj] = xr[64 * jj]; }
        f32x4 v[8], xv8[8]; float s = 0.f;
#pragma unroll
        for (int j = 0; j < 8; ++j) { const unsigned z0 = (j & 1) ? zq[j >> 1].z : zq[j >> 1].x, z1 = (j & 1) ? zq[j >> 1].w : zq[j >> 1].y;
            const unsigned x0 = (j & 1) ? xq[j >> 1].z : xq[j >> 1].x, x1 = (j & 1) ? xq[j >> 1].w : xq[j >> 1].y;
            v[j] = (f32x4){bflo(z0), bfhi(z0), bflo(z1), bfhi(z1)};
            xv8[j] = (f32x4){bflo(x0) * ir0 * igp[j][0], bfhi(x0) * ir0 * igp[j][1], bflo(x1) * ir0 * igp[j][2], bfhi(x1) * ir0 * igp[j][3]};
            s += (v[j][0] * v[j][0] + v[j][1] * v[j][1]) + (v[j][2] * v[j][2] + v[j][3] * v[j][3]); }
        const float r1 = rsqrtf(wave_sum(s) * (1.f / DM) + EPS);
        float s2 = 0.f;
#pragma unroll
        for (int j = 0; j < 8; ++j) { const f32x4 gg = gpo[j]; const f32x4 xv = xv8[j]; f32x4 hv;
            hv[0] = xv[0] + v[j][0] * r1 * gg[0]; hv[1] = xv[1] + v[j][1] * r1 * gg[1]; hv[2] = xv[2] + v[j][2] * r1 * gg[2]; hv[3] = xv[3] + v[j][3] * r1 * gg[3];
            v[j] = hv; s2 += (hv[0] * hv[0] + hv[1] * hv[1]) + (hv[2] * hv[2] + hv[3] * hv[3]); }
        const float r2 = rsqrtf(wave_sum(s2) * (1.f / DM) + EPS);
        if (lane == 0) R2[row] = r2;
        u32x4* h16 = (u32x4*)(H1B + (size_t)row * DM) + lane;
#pragma unroll
        for (int jj = 0; jj < 4; ++jj) { const f32x4 p = v[2 * jj], q = v[2 * jj + 1]; u32x4 hw;
            hw.x = cvtpk(p[0], p[1]); hw.y = cvtpk(p[2], p[3]); hw.z = cvtpk(q[0], q[1]); hw.w = cvtpk(q[2], q[3]); h16[64 * jj] = hw; }
    }
    }
    xcd_barrier(gbar);

    {
        pg8::Gemm g{H1B, WGU_T, MTOK, 2 * DFF, DM, DM, DM}; pg8::StaticOrder S; S.init(MTOK, 2 * DFF, G, bx);
        pg8::EpiSwiGLU E{FFH, DFF, R2};
        pg8::gemm_phase<pg8::EpiSwiGLU, pg8::StaticOrder, true, true>(lds, g, S, E);
    }
    xcd_barrier(gbar);

    {
        pg8::Gemm g{FFH, WDN_T, MTOK, DM, DFF, DFF, DFF}; pg8::StaticOrder S; S.init(MTOK, DM, G, bx);
        pg8::EpiPlain E{Z2, DM};
        pg8::gemm_phase<pg8::EpiPlain, pg8::StaticOrder, true, true>(lds, g, S, E);
    }
    xcd_barrier(gbar);

    {
    int lane = threadIdx.x & 63; asm volatile("" : "+v"(lane));
    int gw = bx * NWAVES + __builtin_amdgcn_readfirstlane(threadIdx.x >> 6); asm volatile("" : "+s"(gw));
    f32x4 gfo[8];
#pragma unroll
    for (int j = 0; j < 8; ++j) gfo[j] = ((const f32x4*)g_fpost)[128 * (j >> 1) + 2 * lane + (j & 1)];
    for (int row = gw; row < MTOK; row += ngw) {
        const u32x4* zr = (const u32x4*)(Z2 + (size_t)row * DM) + lane; const u32x4* hr = (const u32x4*)(H1B + (size_t)row * DM) + lane;
        f32x4* orow = (f32x4*)(out + (size_t)row * DM) + 2 * lane;
        u32x4 zq[4], hq[4];
#pragma unroll
        for (int jj = 0; jj < 4; ++jj) { zq[jj] = zr[64 * jj]; hq[jj] = hr[64 * jj]; }
        f32x4 v[8]; float s = 0.f;
#pragma unroll
        for (int j = 0; j < 8; ++j) { const unsigned z0 = (j & 1) ? zq[j >> 1].z : zq[j >> 1].x, z1 = (j & 1) ? zq[j >> 1].w : zq[j >> 1].y;
            v[j] = (f32x4){bflo(z0), bfhi(z0), bflo(z1), bfhi(z1)}; s += (v[j][0] * v[j][0] + v[j][1] * v[j][1]) + (v[j][2] * v[j][2] + v[j][3] * v[j][3]); }
        const float r1 = rsqrtf(wave_sum(s) * (1.f / DM) + EPS);
#pragma unroll
        for (int j = 0; j < 8; ++j) { const f32x4 gg = gfo[j]; const unsigned h0 = (j & 1) ? hq[j >> 1].z : hq[j >> 1].x, h1_ = (j & 1) ? hq[j >> 1].w : hq[j >> 1].y;
            f32x4 hv = (f32x4){bflo(h0), bfhi(h0), bflo(h1_), bfhi(h1_)};
            hv[0] += v[j][0] * r1 * gg[0]; hv[1] += v[j][1] * r1 * gg[1]; hv[2] += v[j][2] * r1 * gg[2]; hv[3] += v[j][3] * r1 * gg[3]; __builtin_nontemporal_store(hv, &orow[128 * (j >> 1) + (j & 1)]); }
    }
    }
}

extern "C" void kernel_launch(void* const* d_in, const int* in_sizes, int n_in, void* d_out, int out_size, void* d_ws, size_t ws_size, hipStream_t stream) {
    static int grid = 0;
    if (grid == 0) {
        if (n_in != 13 || out_size != MTOK * DM || ws_size < WS_END) { fprintf(stderr, "kernel_launch: unexpected shapes (n_in %d out %d ws %zu)\n", n_in, out_size, ws_size); grid = -1; return; }
        int dev = 0, cus = 0, per_cu = 0;
        hipGetDevice(&dev); hipDeviceGetAttribute(&cus, hipDeviceAttributeMultiprocessorCount, dev);
        hipFuncSetAttribute((const void*)fwd_megakernel, hipFuncAttributeMaxDynamicSharedMemorySize, LDS_BYTES);
        hipOccupancyMaxActiveBlocksPerMultiprocessor(&per_cu, (const void*)fwd_megakernel, NTHR, LDS_BYTES);
        if (per_cu < 1) per_cu = 1;
        (void)hipGetLastError();
        grid = cus;
    }
    if (grid < 0) return;
    Args a{};
    for (int i = 0; i < 13; ++i) a.in[i] = (const float*)d_in[i];
    a.out = (float*)d_out; a.ws = (unsigned char*)d_ws;
    for (int i = 0; i < 64; ++i) a.inv_freq[i] = (float)pow(10000.0, -(double)(2 * i) / 128.0);
    (void)hipMemsetAsync((unsigned char*)d_ws + WS_BAR, 0, WS_BAR_BYTES, stream);
    void* kargs[] = {&a};
    hipError_t e = hipLaunchCooperativeKernel((const void*)fwd_megakernel, dim3(grid), dim3(NTHR), kargs, LDS_BYTES, stream);
    if (e != hipSuccess) fprintf(stderr, "cooperative launch failed: %s (grid %d)\n", hipGetErrorString(e), grid);
}
```
